# Optimizing an MI355X kernel written in HIP

```python
import math
import jax, jax.numpy as jnp
from jax import lax
import numpy as np

D_MODEL = 1024
BATCH = 2
SEQ = 16384
DEPTH = 2
DEC_BATCH = 8
DEC_SEQ = 8192
PAST_LEN = 128

HEAD_DIM = 64
POOL_WINDOWS = (2, 4, 8, 16)
POOL_GROUPS = len(POOL_WINDOWS)
POOL_WIDTH = D_MODEL // 4
POOL_GROUP_DIM = POOL_WIDTH // POOL_GROUPS
ATTN_WIDTH = D_MODEL // 2
ATTN_HEADS = ATTN_WIDTH // HEAD_DIM
DILATED_PATTERNS = ((128, 1), (512, 4), (2048, 16))
ROT_DIM = HEAD_DIM // 4
ROPE_THETA = 500000.0
SGU_WIDTH = D_MODEL // 4
SGU_GROUPS = 4
SGU_GROUP_DIM = SGU_WIDTH // SGU_GROUPS
SGU_CHUNK = 128
MIX_WIDTH = POOL_WIDTH + ATTN_WIDTH + SGU_WIDTH
PROJ_WIDTH = POOL_WIDTH + 3 * ATTN_WIDTH + 2 * SGU_WIDTH
D_FF = 4 * D_MODEL
N_MOD = 6
EPS = 1e-6
MASK_VALUE = -1e30

kernel_name = "hybrid_pool_dilated_sgu_encoder"


def rms_norm(x, g):
    xf = x.astype(jnp.float32)
    y = xf * lax.rsqrt(jnp.mean(xf * xf, axis=-1, keepdims=True) + EPS)
    return (y * g.astype(jnp.float32)).astype(x.dtype)


def pool_mixer(h, pool_w, pool_scale):
    B, S, _ = h.shape
    hf = h.astype(jnp.float32).reshape(B, S, POOL_GROUPS, POOL_GROUP_DIM)
    cs = jnp.concatenate([jnp.zeros((B, 1, POOL_GROUPS, POOL_GROUP_DIM), jnp.float32),
                          jnp.cumsum(hf, axis=1)], axis=1)
    pos = jnp.arange(S)
    outs = []
    for g, win in enumerate(POOL_WINDOWS):
        lo = jnp.clip(pos - win // 2, 0, S)
        hi = jnp.clip(pos + win // 2, 0, S)
        win_sum = cs[:, hi, g] - cs[:, lo, g]
        cnt = (hi - lo).astype(jnp.float32)[None, :, None]
        outs.append(win_sum / cnt - hf[:, :, g])
    p = jnp.stack(outs, axis=2).astype(h.dtype)
    y = jnp.einsum('bsgc,gcd->bsgd', p, pool_w).reshape(B, S, POOL_WIDTH)
    return y * pool_scale


def partial_rotary(x, pos):
    inv_freq = ROPE_THETA ** (-jnp.arange(0, ROT_DIM, 2, dtype=jnp.float32) / ROT_DIM)
    ang = pos.astype(jnp.float32)[:, None] * inv_freq[None, :]
    cos = jnp.cos(ang)[None, :, None, :]
    sin = jnp.sin(ang)[None, :, None, :]
    xf = x.astype(jnp.float32)
    x1 = xf[..., :ROT_DIM // 2]
    x2 = xf[..., ROT_DIM // 2:ROT_DIM]
    out = jnp.concatenate([x1 * cos - x2 * sin, x2 * cos + x1 * sin, xf[..., ROT_DIM:]], axis=-1)
    return out.astype(x.dtype)


def band_attention(q, k, v, half):
    N, L, H, dh = q.shape
    blk = half
    nb = -(-L // blk)
    Lp = nb * blk
    qb = jnp.pad(q, ((0, 0), (0, Lp - L), (0, 0), (0, 0))).reshape(N, nb, blk, H, dh)

    def neighbourhood(t):
        tb = jnp.pad(t, ((0, 0), (blk, Lp - L + blk), (0, 0), (0, 0))).reshape(N, nb + 2, blk, H, dh)
        return jnp.concatenate([tb[:, :-2], tb[:, 1:-1], tb[:, 2:]], axis=2)

    kb = neighbourhood(k)
    vb = neighbourhood(v)
    qpos = jnp.arange(Lp).reshape(nb, blk)
    kpos = jnp.arange(nb)[:, None] * blk - blk + jnp.arange(3 * blk)[None, :]
    valid = ((jnp.abs(qpos[:, :, None] - kpos[:, None, :]) <= half)
             & (kpos[:, None, :] >= 0) & (kpos[:, None, :] < L))
    s = jnp.einsum('nbqhd,nbkhd->nbhqk', qb, kb).astype(jnp.float32) * (dh ** -0.5)
    s = jnp.where(valid[None, :, None], s, MASK_VALUE)
    m = jnp.max(s, axis=-1)
    p = jnp.exp(s - m[..., None])
    l = jnp.sum(p, axis=-1)
    o = jnp.einsum('nbhqk,nbkhd->nbqhd', p, vb.astype(jnp.float32))
    o = o / jnp.transpose(l, (0, 1, 3, 2))[..., None]
    o = o.reshape(N, Lp, H, dh)[:, :L]
    m = jnp.transpose(m, (0, 1, 3, 2)).reshape(N, Lp, H)[:, :L]
    l = jnp.transpose(l, (0, 1, 3, 2)).reshape(N, Lp, H)[:, :L]
    return o, m, l


def dilated_attention(q, k, v):
    B, S, H, dh = q.shape
    outs, ms, ls = [], [], []
    for win, d in DILATED_PATTERNS:
        half = win // (2 * d)
        Ld = S // d

        def fold(t):
            return t.reshape(B, Ld, d, H, dh).transpose(0, 2, 1, 3, 4).reshape(B * d, Ld, H, dh)

        o, m, l = band_attention(fold(q), fold(k), fold(v), half)
        outs.append(o.reshape(B, d, Ld, H, dh).transpose(0, 2, 1, 3, 4).reshape(B, S, H, dh))
        ms.append(m.reshape(B, d, Ld, H).transpose(0, 2, 1, 3).reshape(B, S, H))
        ls.append(l.reshape(B, d, Ld, H).transpose(0, 2, 1, 3).reshape(B, S, H))
    m_all = jnp.stack(ms)
    wts = jnp.stack(ls) * jnp.exp(m_all - jnp.max(m_all, axis=0, keepdims=True))
    o = jnp.sum(wts[..., None] * jnp.stack(outs), axis=0) / jnp.sum(wts, axis=0)[..., None]
    return o


def spatial_gating(z, sgu_w, sgu_b):
    B, S, _ = z.shape
    u, v = z[..., :SGU_WIDTH], z[..., SGU_WIDTH:]
    vf = v.astype(jnp.float32).reshape(B, S // SGU_CHUNK, SGU_CHUNK, SGU_GROUPS, SGU_GROUP_DIM)
    mu = jnp.mean(vf, axis=-1, keepdims=True)
    var = jnp.mean(jnp.square(vf - mu), axis=-1, keepdims=True)
    vn = ((vf - mu) * lax.rsqrt(var + EPS)).astype(z.dtype)
    vm = jnp.einsum('gpq,bnqgc->bnpgc', sgu_w, vn) + jnp.transpose(sgu_b)[None, None, :, :, None]
    return u * vm.reshape(B, S, SGU_WIDTH)


def mixer(h, w_in, pool_w, pool_scale, sgu_w, sgu_b, w_out):
    B, S, _ = h.shape
    z = h @ w_in
    o1 = POOL_WIDTH
    o2 = o1 + ATTN_WIDTH
    o3 = o2 + ATTN_WIDTH
    o4 = o3 + ATTN_WIDTH
    za, zq, zk, zv, zc = z[..., :o1], z[..., o1:o2], z[..., o2:o3], z[..., o3:o4], z[..., o4:]
    ya = pool_mixer(za, pool_w, pool_scale)
    pos = jnp.arange(S)
    q = partial_rotary(zq.reshape(B, S, ATTN_HEADS, HEAD_DIM), pos)
    k = partial_rotary(zk.reshape(B, S, ATTN_HEADS, HEAD_DIM), pos)
    v = zv.reshape(B, S, ATTN_HEADS, HEAD_DIM)
    yb = dilated_attention(q, k, v).astype(h.dtype).reshape(B, S, ATTN_WIDTH)
    yc = spatial_gating(jax.nn.gelu(zc), sgu_w, sgu_b)
    return jnp.concatenate([ya, yb, yc], axis=-1) @ w_out


def trunk(x, c, w_ada, b_ada, g_mix, g_mlp, w_in, pool_w, pool_scale, sgu_w, sgu_b,
          w_out, w_up, w_down, g_final):
    c_act = jax.nn.silu(c)
    for l in range(DEPTH):
        mod = (c_act @ w_ada[l] + b_ada[l])[:, None, :]
        sh1, sc1, gt1, sh2, sc2, gt2 = jnp.split(mod, N_MOD, axis=-1)
        h = rms_norm(x, g_mix[l]) * (1 + sc1) + sh1
        x = x + gt1 * mixer(h, w_in[l], pool_w[l], pool_scale[l], sgu_w[l], sgu_b[l], w_out[l])
        h = rms_norm(x, g_mlp[l]) * (1 + sc2) + sh2
        x = x + gt2 * (jnp.square(jax.nn.relu(h @ w_up[l])) @ w_down[l])
    return rms_norm(x, g_final)


def setup_inputs(seed: int = 0) -> dict:
    key = jax.random.key(seed)
    ks = jax.random.split(key, 20)
    f32 = jnp.float32
    nrm = lambda k, shape, s: jax.random.normal(k, shape, f32) * s
    return {
        "x_prompt": nrm(ks[0], (BATCH, SEQ, D_MODEL), 1.0),
        "x_sample": nrm(ks[1], (DEC_BATCH, DEC_SEQ, D_MODEL), 1.0),
        "c_prompt": nrm(ks[2], (BATCH, D_MODEL), 1.0),
        "c_sample": nrm(ks[3], (DEC_BATCH, D_MODEL), 1.0),
        "w_ada": nrm(ks[4], (DEPTH, D_MODEL, N_MOD * D_MODEL), 0.5 * D_MODEL ** -0.5),
        "b_ada": nrm(ks[5], (DEPTH, N_MOD * D_MODEL), 0.02),
        "g_mix": 1.0 + nrm(ks[6], (DEPTH, D_MODEL), 0.02),
        "g_mlp": 1.0 + nrm(ks[7], (DEPTH, D_MODEL), 0.02),
        "w_in": nrm(ks[8], (DEPTH, D_MODEL, PROJ_WIDTH), D_MODEL ** -0.5),
        "pool_w": nrm(ks[9], (DEPTH, POOL_GROUPS, POOL_GROUP_DIM, POOL_GROUP_DIM), POOL_GROUP_DIM ** -0.5),
        "pool_scale": 1.0 + nrm(ks[10], (DEPTH, POOL_WIDTH), 0.02),
        "sgu_w": nrm(ks[11], (DEPTH, SGU_GROUPS, SGU_CHUNK, SGU_CHUNK), SGU_CHUNK ** -0.5),
        "sgu_b": 1.0 + nrm(ks[12], (DEPTH, SGU_GROUPS, SGU_CHUNK), 0.02),
        "w_out": nrm(ks[13], (DEPTH, MIX_WIDTH, D_MODEL), MIX_WIDTH ** -0.5),
        "w_up": nrm(ks[14], (DEPTH, D_MODEL, D_FF), D_MODEL ** -0.5),
        "w_down": nrm(ks[15], (DEPTH, D_FF, D_MODEL), D_FF ** -0.5),
        "g_final": 1.0 + nrm(ks[16], (D_MODEL,), 0.02),
    }


def reference(x_prompt, x_sample, c_prompt, c_sample, w_ada, b_ada, g_mix, g_mlp, w_in, pool_w,
              pool_scale, sgu_w, sgu_b, w_out, w_up, w_down, g_final):
    y_prompt = trunk(x_prompt, c_prompt, w_ada, b_ada, g_mix, g_mlp, w_in, pool_w, pool_scale,
                     sgu_w, sgu_b, w_out, w_up, w_down, g_final)
    y_sample = trunk(x_sample, c_sample, w_ada, b_ada, g_mix, g_mlp, w_in, pool_w, pool_scale,
                     sgu_w, sgu_b, w_out, w_up, w_down, g_final)
    return (y_prompt, y_sample)
```

```cpp
#include <hip/hip_runtime.h>
#include <hip/hip_cooperative_groups.h>
#include <cstdio>
#include <cstdint>
namespace cg = cooperative_groups;
__device__ __forceinline__ int opaque_tid() { int t = threadIdx.x; asm volatile("" : "+v"(t)); return t; }
namespace pg8 {
#define PG8_LAS __attribute__((address_space(3)))
typedef unsigned short bf16_t;
typedef short bf16x8 __attribute__((ext_vector_type(8)));
typedef float f32x4 __attribute__((ext_vector_type(4)));
typedef unsigned u32x4 __attribute__((ext_vector_type(4)));
constexpr int BM = 256, BK = 64, HALF = 128, HTB = HALF * BK * 2  , STAGE_BYTES = 8 * HTB, NXCD = 8, WGM = 8;

__host__ __device__ __forceinline__ int lds_byte(int r, int c) { const int st = (r >> 4) * 2 + (c >> 5), rr = r & 15, cc = c & 31, ob = rr * 64 + cc * 2; return st * 1024 + (ob ^ (((ob >> 9) & 1) << 5)); }
__host__ __device__ __forceinline__ void stage_rc(int b, int& R, int& C) { const int st = b / 1024, sb = b % 1024, swz = sb ^ (((sb >> 9) & 1) << 5); R = (st >> 1) * 16 + swz / 64; C = (st & 1) * 32 + (swz % 64) / 2; }
__host__ __device__ __forceinline__ int perm32(int rho) { const int n = rho >> 4, i = rho & 15; return 8 * (i >> 2) + 4 * n + (i & 3); }

struct Unit { int pm, pn; };
struct Gemm { const bf16_t* A; const bf16_t* Bt; int M, N, K; };

struct StaticOrder {
    int nM, nN, nwg, G, c, rev;
    __host__ __device__ void init(int M, int N, int G_, int c_, int rev_ = 0) { nM = M / BM; nN = N / BM; nwg = nM * nN; G = G_; c = c_; rev = rev_; }
    __host__ __device__ bool next(int i, Unit& u) const {
        const long L = (long)i * G + c; if (L >= nwg) return false;
        int wgid = (int)L; { const int q = nwg / NXCD, r = nwg % NXCD, xcd = wgid % NXCD; int off = wgid / NXCD; if (rev && r == 0) off = q - 1 - off; wgid = (xcd < r ? xcd * (q + 1) : r * (q + 1) + (xcd - r) * q) + off; }
        const int nig = WGM * nN, gid = wgid / nig, fm = gid * WGM, gsz = (nM - fm) < WGM ? (nM - fm) : WGM;
        u.pm = fm + ((wgid % nig) % gsz); u.pn = (wgid % nig) / gsz; return true;
    }
    __device__ __forceinline__ void a_ready(const Unit&) const {}
    __device__ __forceinline__ void done(const Unit&) const {}
};


typedef float f32x2 __attribute__((ext_vector_type(2)));
__device__ __forceinline__ unsigned cvt_pk_bf16(float lo, float hi) { typedef __bf16 b2 __attribute__((ext_vector_type(2))); f32x2 v = {lo, hi}; b2 b = __builtin_convertvector(v, b2); return __builtin_bit_cast(unsigned, b); }
__device__ __forceinline__ void tile_info(int pm, int& b, int& pos0) {
    if (pm < 128) { b = pm >> 6; pos0 = (pm & 63) << 8; } else { const int q = pm - 128; b = 2 + (q >> 5); pos0 = (q & 31) << 8; }
}
__device__ __forceinline__ float gelu_tanh(float x) {
    const float y = x * (1.0f + 0.044715f * x * x) * (2.0f * 0.7978845608028654f);
    const float e = __builtin_amdgcn_exp2f(-y * 1.4426950408889634f);
    return x * __builtin_amdgcn_rcpf(1.0f + e);
}
struct EpiZ {
    static constexpr bool PERM = true, AFTER_DRAIN = false;
    bf16_t* Z; const float* rope;
    const float* rowsq; const float* shw;
    __device__ __forceinline__ void operator()(const f32x4 (&acc)[2][2][4][2], const Unit& u, int wr, int wc, int fr_, int fq) const {
        int fr = fr_; asm volatile("" : "+v"(fr));
        int b, pos0; tile_info(u.pm, b, pos0);
        const int pn = u.pn;
        const bool rot = (pn >= 1 && pn <= 4) && ((wc & 1) == 0);
        const bool gel = (pn >= 7);
        const float qs = (pn == 1 || pn == 2) ? 0.125f * 1.4426950408889634f : 1.0f;
        const int row0 = u.pm * BM + wr * 64 + fr;
        const int col0 = pn * BM + wc * 32 + 8 * fq;
        f32x4 sv[2][2];
#pragma unroll
        for (int bj = 0; bj < 2; ++bj)
#pragma unroll
            for (int n = 0; n < 2; ++n) sv[bj][n] = *(const f32x4*)(shw + (size_t)b * 2304 + col0 + bj * HALF + 4 * n);
#pragma unroll
        for (int ai = 0; ai < 2; ++ai)
#pragma unroll
            for (int m = 0; m < 4; ++m) {
                const int rl = ai * HALF + m * 16;
                bf16_t* rowp = Z + (size_t)(row0 + rl) * 2304 + col0;
                const float rr = 1.0f / sqrtf(rowsq[row0 + rl] * (1.0f / 1024.0f) + 1e-6f);
                f32x4 cs[4];
                if (rot) { const f32x4* rp = (const f32x4*)(rope + (size_t)(pos0 + wr * 64 + fr + rl) * 16);
#pragma unroll
                    for (int i = 0; i < 4; ++i) cs[i] = rp[i]; }
#pragma unroll
                for (int bj = 0; bj < 2; ++bj) {
                    f32x4 v0 = acc[ai][bj][m][0] * rr + sv[bj][0], v1 = acc[ai][bj][m][1] * rr + sv[bj][1];
                    if (rot) {
                        f32x4 p0, p1;
#pragma unroll
                        for (int j = 0; j < 4; ++j) { p0[j] = __shfl_xor(v0[j], 16); p1[j] = __shfl_xor(v1[j], 16); }
                        const float sg = (fq == 0) ? -1.0f : 1.0f;
                        if (fq < 2) {
                            f32x4 r0, r1;
                            r0[0] = v0[0] * cs[0][0] + sg * p0[0] * cs[0][1]; r0[1] = v0[1] * cs[0][2] + sg * p0[1] * cs[0][3];
                            r0[2] = v0[2] * cs[1][0] + sg * p0[2] * cs[1][1]; r0[3] = v0[3] * cs[1][2] + sg * p0[3] * cs[1][3];
                            r1[0] = v1[0] * cs[2][0] + sg * p1[0] * cs[2][1]; r1[1] = v1[1] * cs[2][2] + sg * p1[1] * cs[2][3];
                            r1[2] = v1[2] * cs[3][0] + sg * p1[2] * cs[3][1]; r1[3] = v1[3] * cs[3][2] + sg * p1[3] * cs[3][3];
                            v0 = r0; v1 = r1;
                        }
                    }
                    if (gel) {
#pragma unroll
                        for (int j = 0; j < 4; ++j) { v0[j] = gelu_tanh(v0[j]); v1[j] = gelu_tanh(v1[j]); }
                    }
                    v0 = v0 * qs; v1 = v1 * qs;
                    u32x4 w; w.x = cvt_pk_bf16(v0[0], v0[1]); w.y = cvt_pk_bf16(v0[2], v0[3]); w.z = cvt_pk_bf16(v1[0], v1[1]); w.w = cvt_pk_bf16(v1[2], v1[3]);
                    *(u32x4*)(rowp + bj * HALF) = w;
                }
            }
    }
};
struct EpiRelu2 {
    static constexpr bool PERM = true, AFTER_DRAIN = false;
    bf16_t* O; int ldc; const float* rowsq; const float* shw;
    __device__ __forceinline__ void operator()(const f32x4 (&acc)[2][2][4][2], const Unit& u, int wr, int wc, int fr_, int fq) const {
        int fr = fr_; asm volatile("" : "+v"(fr));
        int b, pos0; tile_info(u.pm, b, pos0);
        const int row0 = u.pm * BM + wr * 64 + fr; const int col0 = u.pn * BM + wc * 32 + 8 * fq;
        f32x4 sv[2][2];
#pragma unroll
        for (int bj = 0; bj < 2; ++bj)
#pragma unroll
            for (int n = 0; n < 2; ++n) sv[bj][n] = *(const f32x4*)(shw + (size_t)b * 4096 + col0 + bj * HALF + 4 * n);
#pragma unroll
        for (int ai = 0; ai < 2; ++ai)
#pragma unroll
            for (int m = 0; m < 4; ++m) { bf16_t* rowp = O + (size_t)(row0 + ai * HALF + m * 16) * ldc + col0;
                const float rr = 1.0f / sqrtf(rowsq[row0 + ai * HALF + m * 16] * (1.0f / 1024.0f) + 1e-6f);
#pragma unroll
                for (int bj = 0; bj < 2; ++bj) { f32x4 v0 = acc[ai][bj][m][0] * rr + sv[bj][0], v1 = acc[ai][bj][m][1] * rr + sv[bj][1];
#pragma unroll
                    for (int j = 0; j < 4; ++j) { const float a = fmaxf(v0[j], 0.f), c = fmaxf(v1[j], 0.f); v0[j] = a * a; v1[j] = c * c; }
                    u32x4 w; w.x = cvt_pk_bf16(v0[0], v0[1]); w.y = cvt_pk_bf16(v0[2], v0[3]); w.z = cvt_pk_bf16(v1[0], v1[1]); w.w = cvt_pk_bf16(v1[2], v1[3]);
                    *(u32x4*)(rowp + bj * HALF) = w; } }
    }
};
struct EpiRes {
    static constexpr bool PERM = true, AFTER_DRAIN = false;
    const float* xin_p; const float* xin_s;
    const bf16_t* Hin; const float* gin; const float* scin;
    const float* gate;
    bf16_t* Hn; const float* gn; const float* scn;
    float* rowsq;
    __device__ __forceinline__ void operator()(const f32x4 (&acc)[2][2][4][2], const Unit& u, int wr, int wc, int fr_, int fq) const {
        int fr = fr_; asm volatile("" : "+v"(fr));
        int b, pos0; tile_info(u.pm, b, pos0);
        const float* base = (u.pm < 128) ? xin_p + (size_t)(u.pm * BM) * 1024 : xin_s + (size_t)(u.pm * BM - 32768) * 1024;
        const size_t hrow = (size_t)(u.pm * BM) * 1024;
        const int col0 = u.pn * BM + wc * 32 + 8 * fq;
        float ss[8];
#pragma unroll
        for (int i = 0; i < 8; ++i) ss[i] = 0.f;
#pragma unroll
        for (int bj = 0; bj < 2; ++bj) {
            const int c = col0 + bj * HALF;
            f32x4 gv[2], gs[2], gi[2];
#pragma unroll
            for (int n = 0; n < 2; ++n) {
                gv[n] = *(const f32x4*)(gate + (size_t)b * 6144 + c + 4 * n);
                gs[n] = *(const f32x4*)(gn + c + 4 * n);
                if (scn) gs[n] = gs[n] * (*(const f32x4*)(scn + (size_t)b * 6144 + c + 4 * n) + 1.0f);
                gi[n] = (f32x4){1.f, 1.f, 1.f, 1.f};
                if (Hin) { const f32x4 t = *(const f32x4*)(gin + c + 4 * n) * (*(const f32x4*)(scin + (size_t)b * 6144 + c + 4 * n) + 1.0f);
                    gi[n] = (f32x4){1.0f / t[0], 1.0f / t[1], 1.0f / t[2], 1.0f / t[3]}; }
            }
#pragma unroll
            for (int ai = 0; ai < 2; ++ai)
#pragma unroll
                for (int m = 0; m < 4; ++m) { const int rl = ai * HALF + wr * 64 + m * 16 + fr; const size_t off = (size_t)rl * 1024 + c;
                    f32x4 x0, x1;
                    if (Hin) { const u32x4 hv = *(const u32x4*)(Hin + hrow + off);
                        x0 = (f32x4){__uint_as_float(hv.x << 16), __uint_as_float(hv.x & 0xffff0000u), __uint_as_float(hv.y << 16), __uint_as_float(hv.y & 0xffff0000u)} * gi[0];
                        x1 = (f32x4){__uint_as_float(hv.z << 16), __uint_as_float(hv.z & 0xffff0000u), __uint_as_float(hv.w << 16), __uint_as_float(hv.w & 0xffff0000u)} * gi[1]; }
                    else { x0 = *(const f32x4*)(base + off); x1 = *(const f32x4*)(base + off + 4); }
                    const f32x4 o0 = x0 + gv[0] * acc[ai][bj][m][0], o1 = x1 + gv[1] * acc[ai][bj][m][1];
                    ss[ai * 4 + m] += (o0[0] * o0[0] + o0[1] * o0[1]) + (o0[2] * o0[2] + o0[3] * o0[3]) + (o1[0] * o1[0] + o1[1] * o1[1]) + (o1[2] * o1[2] + o1[3] * o1[3]);
                    const f32x4 h0 = o0 * gs[0], h1 = o1 * gs[1];
                    u32x4 w; w.x = cvt_pk_bf16(h0[0], h0[1]); w.y = cvt_pk_bf16(h0[2], h0[3]); w.z = cvt_pk_bf16(h1[0], h1[1]); w.w = cvt_pk_bf16(h1[2], h1[3]);
                    *(u32x4*)(Hn + hrow + off) = w;
                }
            asm volatile("" ::: "memory");
        }
#pragma unroll
        for (int ai = 0; ai < 2; ++ai)
#pragma unroll
            for (int m = 0; m < 4; ++m) { float s = ss[ai * 4 + m]; s += __shfl_xor(s, 16); s += __shfl_xor(s, 32);
                if (fq == 0) __hip_atomic_fetch_add(rowsq + u.pm * BM + ai * HALF + wr * 64 + m * 16 + fr, s, __ATOMIC_RELAXED, __HIP_MEMORY_SCOPE_AGENT); }
    }
};

template <class Epi, class Sched, bool ALIGN_EPI = false, bool SP2 = false>
__device__ __forceinline__ void gemm_phase(PG8_LAS unsigned char* lds, const Gemm g, const Sched& S, const Epi& E) {
    const int tid = opaque_tid(), wid = __builtin_amdgcn_readfirstlane(tid >> 6), lane = tid & 63, wr = wid >> 2, wc = wid & 3, fr = lane & 15, fq = lane >> 4;
    const int K = g.K, nt = K / BK;
    unsigned voffA[2], voffB[2];
#pragma unroll
    for (int i = 0; i < 2; ++i) { int R, C; stage_rc(tid * 16 + i * 8192, R, C); const int Rb = Epi::PERM ? ((R & ~31) + perm32(R & 31)) : R;
        voffA[i] = (unsigned)(R * K + C) * 2u; voffB[i] = (unsigned)(Rb * K + C) * 2u; }
    const size_t kstep = (size_t)(BK * 2);
    const size_t hstep = (size_t)HALF * K * 2;
    const size_t tstep = 2 * hstep;
    const unsigned ldsw = (unsigned)wid * 1024u;
    const int aoff = lds_byte(wr * 64 + fr, fq * 8), boff = lds_byte(wc * 32 + fr, fq * 8);
#define PG8_SA(b, h) (((b) * 2 + (h)) * HTB)
#define PG8_SB(b, h) ((4 + (b) * 2 + (h)) * HTB)
#define PG8_STAGE(bufoff, gbase, voff) do { _Pragma("unroll") for (int _i = 0; _i < 2; ++_i) \
        __builtin_amdgcn_global_load_lds((const unsigned*)((const char*)(gbase) + (voff)[_i]), (PG8_LAS unsigned*)(lds + (bufoff) + ldsw + _i * 8192), 16, 0, 0); } while (0)
#define PG8_LDA(dst, b, h) do { _Pragma("unroll") for (int m = 0; m < 4; ++m) _Pragma("unroll") for (int k = 0; k < 2; ++k) dst[m][k] = *(const PG8_LAS bf16x8*)(lds + PG8_SA(b, h) + aoff + m * 2048 + k * 1024); } while (0)
#define PG8_LDB(dst, b, h) do { _Pragma("unroll") for (int n = 0; n < 2; ++n) _Pragma("unroll") for (int k = 0; k < 2; ++k) dst[n][k] = *(const PG8_LAS bf16x8*)(lds + PG8_SB(b, h) + boff + n * 2048 + k * 1024); } while (0)
#define PG8_MMA(ai, bj, At, Bt) do { __builtin_amdgcn_s_setprio(1); _Pragma("unroll") for (int m = 0; m < 4; ++m) _Pragma("unroll") for (int n = 0; n < 2; ++n) _Pragma("unroll") for (int k = 0; k < 2; ++k) \
        acc[ai][bj][m][n] = __builtin_amdgcn_mfma_f32_16x16x32_bf16(Bt[n][k], At[m][k], acc[ai][bj][m][n], 0, 0, 0); __builtin_amdgcn_s_setprio(0); } while (0)
#define PG8_WAIT_V(n) asm volatile("s_waitcnt vmcnt(" #n ")" ::: "memory")
#define PG8_WAIT_L(n) asm volatile("s_waitcnt lgkmcnt(" #n ")" ::: "memory")
#define PG8_BAR __builtin_amdgcn_s_barrier()
#define PG8_SCHED __builtin_amdgcn_sched_barrier(0)
    Unit cur, nxt; int ui = 0;
    if (!S.next(0, cur)) return;
    f32x4 acc[2][2][4][2];
#pragma unroll
    for (int a = 0; a < 2; ++a)
#pragma unroll
        for (int b = 0; b < 2; ++b)
#pragma unroll
            for (int m = 0; m < 4; ++m)
#pragma unroll
                for (int n = 0; n < 2; ++n) acc[a][b][m][n] = (f32x4){0.f, 0.f, 0.f, 0.f};
    bf16x8 At[4][2], B0[2][2], B1[2][2];
    const char* cA = (const char*)g.A + (size_t)cur.pm * tstep; const char* cB = (const char*)g.Bt + (size_t)cur.pn * tstep;
    S.a_ready(cur);
    if constexpr (SP2) {
        PG8_STAGE(PG8_SB(0, 0), cB, voffB); PG8_STAGE(PG8_SB(0, 1), cB + hstep, voffB); PG8_STAGE(PG8_SA(0, 0), cA, voffA); PG8_STAGE(PG8_SA(0, 1), cA + hstep, voffA);
        if (wr == 1) PG8_BAR;
        PG8_WAIT_V(2); PG8_BAR;
        PG8_STAGE(PG8_SB(1, 0), cB + kstep, voffB); PG8_STAGE(PG8_SA(1, 0), cA + kstep, voffA); PG8_STAGE(PG8_SB(1, 1), cB + hstep + kstep, voffB);
        PG8_WAIT_V(6); PG8_BAR;
    } else {
        PG8_STAGE(PG8_SB(0, 0), cB, voffB); PG8_STAGE(PG8_SA(0, 0), cA, voffA); PG8_STAGE(PG8_SB(0, 1), cB + hstep, voffB); PG8_STAGE(PG8_SA(0, 1), cA + hstep, voffA);
        if (wr == 1) PG8_BAR;
        PG8_WAIT_V(4); PG8_BAR;
        PG8_STAGE(PG8_SB(1, 0), cB + kstep, voffB); PG8_STAGE(PG8_SA(1, 0), cA + kstep, voffA); PG8_STAGE(PG8_SB(1, 1), cB + hstep + kstep, voffB);
        PG8_WAIT_V(6); PG8_BAR;
    }
    for (;;) {
        const bool has_next = S.next(ui + 1, nxt);
        const char* nA = has_next ? (const char*)g.A + (size_t)nxt.pm * tstep : cA; const char* nB = has_next ? (const char*)g.Bt + (size_t)nxt.pn * tstep : cB;
        for (int t = 0; t < nt; t += 2) {
            const bool last = (t == nt - 2);
            const char* a1 = cA + (size_t)(t + 1) * kstep;
            const char* a2 = last ? nA : cA + (size_t)(t + 2) * kstep; const char* b2 = last ? nB : cB + (size_t)(t + 2) * kstep;
            const char* a3 = a2 + kstep; const char* b3 = b2 + kstep;
            if (last && has_next) S.a_ready(nxt);
            if constexpr (SP2) {
            PG8_LDB(B0, 0, 0); PG8_LDB(B1, 0, 1); PG8_SCHED; PG8_LDA(At, 0, 0); PG8_STAGE(PG8_SA(1, 1), a1 + hstep, voffA);
            PG8_WAIT_V(8); PG8_WAIT_L(0); PG8_BAR; PG8_MMA(0, 0, At, B0); PG8_MMA(0, 1, At, B1); PG8_BAR; PG8_SCHED;
            PG8_LDA(At, 0, 1); PG8_STAGE(PG8_SB(0, 0), b2, voffB); PG8_STAGE(PG8_SB(0, 1), b2 + hstep, voffB); PG8_STAGE(PG8_SA(0, 0), a2, voffA);
            PG8_WAIT_V(8); PG8_WAIT_L(0); PG8_BAR; PG8_MMA(1, 0, At, B0); PG8_MMA(1, 1, At, B1); PG8_BAR; PG8_SCHED;
            PG8_LDB(B0, 1, 0); PG8_LDB(B1, 1, 1); PG8_SCHED; PG8_LDA(At, 1, 0); PG8_STAGE(PG8_SA(0, 1), a2 + hstep, voffA);
            PG8_WAIT_V(8); PG8_WAIT_L(0); PG8_BAR; PG8_MMA(0, 0, At, B0); PG8_MMA(0, 1, At, B1); PG8_BAR; PG8_SCHED;
            PG8_LDA(At, 1, 1); PG8_STAGE(PG8_SB(1, 0), b3, voffB); PG8_STAGE(PG8_SB(1, 1), b3 + hstep, voffB); PG8_STAGE(PG8_SA(1, 0), a3, voffA);
            PG8_WAIT_V(8); PG8_WAIT_L(0); PG8_BAR; PG8_MMA(1, 0, At, B0); PG8_MMA(1, 1, At, B1); PG8_BAR; PG8_SCHED;
            } else {
            PG8_LDB(B0, 0, 0); PG8_SCHED; PG8_LDA(At, 0, 0); PG8_STAGE(PG8_SA(1, 1), a1 + hstep, voffA);
            PG8_WAIT_L(8); PG8_BAR; PG8_WAIT_L(0); PG8_MMA(0, 0, At, B0); PG8_BAR; PG8_SCHED;
            PG8_LDB(B1, 0, 1); PG8_STAGE(PG8_SB(0, 0), b2, voffB);
            PG8_BAR; PG8_WAIT_L(0); PG8_MMA(0, 1, At, B1); PG8_BAR;
            PG8_LDA(At, 0, 1); PG8_STAGE(PG8_SA(0, 0), a2, voffA);
            PG8_BAR; PG8_WAIT_L(0); PG8_MMA(1, 0, At, B0); PG8_BAR; PG8_SCHED;
            PG8_STAGE(PG8_SB(0, 1), b2 + hstep, voffB);
            PG8_WAIT_V(6); PG8_BAR; PG8_MMA(1, 1, At, B1); PG8_BAR;
            PG8_LDB(B0, 1, 0); PG8_SCHED; PG8_LDA(At, 1, 0); PG8_STAGE(PG8_SA(0, 1), a2 + hstep, voffA);
            PG8_WAIT_L(8); PG8_BAR; PG8_WAIT_L(0); PG8_MMA(0, 0, At, B0); PG8_BAR; PG8_SCHED;
            PG8_LDB(B1, 1, 1); PG8_STAGE(PG8_SB(1, 0), b3, voffB);
            PG8_BAR; PG8_WAIT_L(0); PG8_MMA(0, 1, At, B1); PG8_BAR;
            PG8_LDA(At, 1, 1); PG8_STAGE(PG8_SA(1, 0), a3, voffA);
            PG8_BAR; PG8_WAIT_L(0); PG8_MMA(1, 0, At, B0); PG8_BAR; PG8_SCHED;
            PG8_STAGE(PG8_SB(1, 1), b3 + hstep, voffB);
            PG8_WAIT_V(6); PG8_BAR; PG8_MMA(1, 1, At, B1); PG8_BAR;
            }
        }
        if constexpr (ALIGN_EPI) { if (wr == 0) PG8_BAR; }
        if constexpr (!Epi::AFTER_DRAIN) { E(acc, cur, wr, wc, fr, fq); S.done(cur); }
        if (!has_next) break;
#pragma unroll
        for (int a = 0; a < 2; ++a)
#pragma unroll
            for (int b = 0; b < 2; ++b)
#pragma unroll
                for (int m = 0; m < 4; ++m)
#pragma unroll
                    for (int n = 0; n < 2; ++n) acc[a][b][m][n] = (f32x4){0.f, 0.f, 0.f, 0.f};
        cur = nxt; cA = nA; cB = nB; ++ui;
        if constexpr (ALIGN_EPI) { if (wr == 1) PG8_BAR; }
    }
    PG8_WAIT_V(0);
    if constexpr (!ALIGN_EPI) { if (wr == 0) PG8_BAR; }
    PG8_BAR;
    if constexpr (Epi::AFTER_DRAIN) { E.fused(acc, cur, wr, wc, fr, fq, lds, wid, lane); S.done(cur); }
#undef PG8_SA
#undef PG8_SB
#undef PG8_STAGE
#undef PG8_LDA
#undef PG8_LDB
#undef PG8_MMA
#undef PG8_WAIT_V
#undef PG8_WAIT_L
#undef PG8_BAR
#undef PG8_SCHED
}
}

#define LAS __attribute__((address_space(3)))
typedef unsigned short bf16_t;
typedef short bf16x8 __attribute__((ext_vector_type(8)));
typedef short bf16x4 __attribute__((ext_vector_type(4)));
typedef float f32x4 __attribute__((ext_vector_type(4)));
typedef float f32x2 __attribute__((ext_vector_type(2)));
typedef unsigned u32x4 __attribute__((ext_vector_type(4)));
typedef unsigned u32x2 __attribute__((ext_vector_type(2)));
typedef short v4i16_t __attribute__((ext_vector_type(4)));

constexpr int NW = 8, NTHR = 512;
constexpr int DM = 1024, TP = 32768, TT = 98304, PROJ = 2304, DFF = 4096, NB = 10;
constexpr float EPS = 1e-6f;
constexpr size_t MiB = 1u << 20;
constexpr size_t WS_WIN = 0, WS_WOUT = 9 * MiB, WS_WUP = 13 * MiB, WS_WDOWN = 29 * MiB;
constexpr size_t WS_MOD = 45 * MiB, WS_ROPE = 46 * MiB, WS_PWT = 47 * MiB, WS_SGUW = 47 * MiB + 512 * 1024;
constexpr size_t WS_ML2 = 48 * MiB, WS_ML3 = 54 * MiB;
constexpr size_t WS_SHW = 45 * MiB + 512 * 1024;
constexpr size_t WS_ROWSQ = 61 * MiB;
constexpr size_t WS_H = 64 * MiB, WS_OP2 = 64 * MiB, WS_OP3 = 160 * MiB;
constexpr size_t WS_U = 256 * MiB, WS_Z = 256 * MiB, WS_Y = 688 * MiB, WS_END = 1024 * MiB;
constexpr int LDS_BYTES = 147456;

struct Args {
    const float *x_p, *x_s, *c_p, *c_s, *w_ada, *b_ada, *g_mix, *g_mlp, *w_in, *pool_w, *pool_scale, *sgu_w, *sgu_b, *w_out, *w_up, *w_down, *g_final;
    float* out; unsigned char* ws; int ph_lo, ph_hi;
};

__device__ __forceinline__ unsigned pk_bf16(float lo, float hi) { return pg8::cvt_pk_bf16(lo, hi); }
__device__ __forceinline__ float bf_lo(unsigned w) { return __uint_as_float(w << 16); }
__device__ __forceinline__ float bf_hi(unsigned w) { return __uint_as_float(w & 0xffff0000u); }
__device__ __forceinline__ bf16x4 tr4(const LAS unsigned char* p) { return __builtin_bit_cast(bf16x4, __builtin_amdgcn_ds_read_tr16_b64_v4i16((LAS v4i16_t*)p)); }
__device__ __forceinline__ f32x4 mfma32(bf16x8 a, bf16x8 b, f32x4 c) { return __builtin_amdgcn_mfma_f32_16x16x32_bf16(a, b, c, 0, 0, 0); }
__device__ __forceinline__ f32x4 mfma16(bf16x4 a, bf16x4 b, f32x4 c) { return __builtin_amdgcn_mfma_f32_16x16x16bf16_1k(a, b, c, 0, 0, 0); }
__device__ __forceinline__ float wave_sum(float v) {
#pragma unroll
    for (int o = 1; o < 64; o <<= 1) v += __shfl_xor(v, o);
    return v;
}
__device__ __forceinline__ void row_info(int row, int& b, int& rb, int& S) {
    if (row < TP) { b = row >> 14; rb = b << 14; S = 16384; } else { const int q = (row - TP) >> 13; b = 2 + q; rb = TP + (q << 13); S = 8192; }
}

__device__ __forceinline__ unsigned f2bf(float f) { unsigned u = __builtin_bit_cast(unsigned, f); return (u + 0x7fffu + ((u >> 16) & 1u)) >> 16; }
__device__ __forceinline__ unsigned pk2(float lo, float hi) { return f2bf(lo) | (f2bf(hi) << 16); }
__device__ __forceinline__ void p0_transpose_item(const float* W, int K, int N, bf16_t* WT, LAS float* scr, int item, int lane) {
    const int nblk = N / 32, kb = item / nblk, nb = item % nblk, k0 = 64 * kb, n0 = 32 * nb;
#pragma unroll 8
    for (int i = 0; i < 32; ++i) { const int kk = 2 * i + (lane >> 5); scr[kk * 33 + (lane & 31)] = W[(size_t)(k0 + kk) * N + n0 + (lane & 31)]; }
    asm volatile("s_waitcnt lgkmcnt(0)" ::: "memory");
    const int c = lane & 7;
#pragma unroll
    for (int j = 0; j < 4; ++j) { const int n = (lane >> 3) + 8 * j; const LAS float* s = scr + (8 * c) * 33 + n;
        u32x4 o; o.x = pk2(s[0 * 33], s[1 * 33]); o.y = pk2(s[2 * 33], s[3 * 33]); o.z = pk2(s[4 * 33], s[5 * 33]); o.w = pk2(s[6 * 33], s[7 * 33]);
        *(u32x4*)(WT + (size_t)(n0 + n) * K + k0 + 8 * c) = o; }
    asm volatile("s_waitcnt lgkmcnt(0)" ::: "memory");
}
__device__ __forceinline__ void p0_prologue(const Args& A, LAS unsigned char* lds) {
    const int tid = opaque_tid(), lane = tid & 63, wave = tid >> 6, G = gridDim.x;
    unsigned char* ws = A.ws;
    {
        LAS float* cact = (LAS float*)lds;
        LAS float* red = (LAS float*)(lds + 40960);
        float* mod = (float*)(ws + WS_MOD);
        bool have = false;
        for (int it = blockIdx.x; it < 192; it += G) {
            if (!have) {
                for (int i = tid; i < NB * DM; i += NTHR) { const int b = i >> 10, k = i & 1023; const float c = (b < 2) ? A.c_p[b * DM + k] : A.c_s[(b - 2) * DM + k];
                    cact[i] = c / (1.0f + __expf(-c)); }
                have = true;
            }
            __syncthreads();
            const int l = it / 96, c0 = (it % 96) * 64, col = c0 + lane, kg = wave;
            float acc[NB];
#pragma unroll
            for (int b = 0; b < NB; ++b) acc[b] = 0.f;
            const float* wp = A.w_ada + ((size_t)l * DM + kg * 128) * 6144 + col;
#pragma unroll 4
            for (int k = 0; k < 128; ++k) { const float w = wp[(size_t)k * 6144];
#pragma unroll
                for (int b = 0; b < NB; ++b) acc[b] += cact[b * DM + kg * 128 + k] * w; }
#pragma unroll
            for (int b = 0; b < NB; ++b) red[(kg * NB + b) * 64 + lane] = acc[b];
            __syncthreads();
            for (int i = tid; i < NB * 64; i += NTHR) { const int b = i >> 6, cc = i & 63; float s = A.b_ada[(size_t)l * 6144 + c0 + cc];
#pragma unroll
                for (int g = 0; g < 8; ++g) s += red[(g * NB + b) * 64 + cc];
                mod[((size_t)l * NB + b) * 6144 + c0 + cc] = s; }
        }
        __syncthreads();
    }
    {
        LAS float* scr = (LAS float*)(lds + wave * 16384);
        const int gw = blockIdx.x * NW + wave, NGW = G * NW;
        constexpr int I_IN = (DM / 64) * (PROJ / 32), I_OUT = (DM / 64) * (DM / 32), I_UP = (DM / 64) * (DFF / 32), I_DN = (DFF / 64) * (DM / 32);
        constexpr int PER_L = I_IN + I_OUT + I_UP + I_DN;
        for (int it = gw; it < 2 * PER_L; it += NGW) {
            const int l = it / PER_L; int r = it % PER_L;
            if (r < I_IN) { p0_transpose_item(A.w_in + (size_t)l * DM * PROJ, DM, PROJ, (bf16_t*)(ws + WS_WIN) + (size_t)l * PROJ * DM, scr, r, lane); continue; } r -= I_IN;
            if (r < I_OUT) { p0_transpose_item(A.w_out + (size_t)l * DM * DM, DM, DM, (bf16_t*)(ws + WS_WOUT) + (size_t)l * DM * DM, scr, r, lane); continue; } r -= I_OUT;
            if (r < I_UP) { p0_transpose_item(A.w_up + (size_t)l * DM * DFF, DM, DFF, (bf16_t*)(ws + WS_WUP) + (size_t)l * DFF * DM, scr, r, lane); continue; } r -= I_UP;
            p0_transpose_item(A.w_down + (size_t)l * DFF * DM, DFF, DM, (bf16_t*)(ws + WS_WDOWN) + (size_t)l * DM * DFF, scr, r, lane);
        }
    }
    const int gt = blockIdx.x * NTHR + tid, NGT = G * NTHR;
    {
        float* rope = (float*)(ws + WS_ROPE);
        for (int e = gt; e < 16384 * 8; e += NGT) {
            const int pos = e >> 3, i = e & 7;
            float fi = 1.0f;
            fi = (i == 1) ? 0.1939227432012558f : fi; fi = (i == 2) ? 0.03760603070259094f : fi; fi = (i == 3) ? 0.007292664609849453f : fi; fi = (i == 4) ? 0.0014142135623842478f : fi;
            fi = (i == 5) ? 0.00027424818836152554f : fi; fi = (i == 6) ? 5.318296098266728e-05f : fi; fi = (i == 7) ? 1.0313386155758053e-05f : fi;
            const float angf = (float)pos * fi;
            const double ang = (double)angf;
            const double TWO_PI = 6.283185307179586476925286766559;
            const double r = ang - TWO_PI * rint(ang / TWO_PI);
            const double r2 = r * r;
            double sn = 0.0, cn = 0.0, ts = r, tc = 1.0;
#pragma unroll 1
            for (int k = 0; k < 14; ++k) { sn += ts; cn += tc; tc = -tc * r2 / (double)((2 * k + 1) * (2 * k + 2)); ts = -ts * r2 / (double)((2 * k + 2) * (2 * k + 3)); }
            rope[2 * e] = (float)cn; rope[2 * e + 1] = (float)sn;
        }
    }
    { float* rz = (float*)(ws + WS_ROWSQ) + TT; for (int e = gt; e < 4 * TT; e += NGT) rz[e] = 0.f; }
    {
        bf16_t* pwt = (bf16_t*)(ws + WS_PWT);
        for (int e = gt; e < 2 * 4 * 64 * 64; e += NGT) { const int c = e & 63, d = (e >> 6) & 63, lg = e >> 12; pwt[e] = (bf16_t)f2bf(A.pool_w[(size_t)lg * 4096 + c * 64 + d]); }
        bf16_t* sw = (bf16_t*)(ws + WS_SGUW);
        for (int e = gt; e < 2 * 4 * 128 * 128; e += NGT) sw[e] = (bf16_t)f2bf(A.sgu_w[e]);
    }
}

__device__ __forceinline__ void prep_phase(const float* xp, const float* xs, const float* g, const float* mod0, bf16_t* H, float* rowsq0, const float* mod, const bf16_t* win_t, const bf16_t* wup_t, float* shw) {
    const int tid = opaque_tid(), lane = tid & 63, wave = tid >> 6;
    const int gw = blockIdx.x * NW + wave, NGW = gridDim.x * NW;
    {
        for (int t = gw; t < 2 * 6400; t += NGW) {
            const int l = t / 6400, r = t - l * 6400; const bool up = (r >= 2304); const int n = up ? r - 2304 : r;
            const bf16_t* wrow = (up ? wup_t + (size_t)l * DFF * DM : win_t + (size_t)l * PROJ * DM) + (size_t)n * DM;
            const u32x4 w0 = *(const u32x4*)(wrow + 8 * lane), w1 = *(const u32x4*)(wrow + 512 + 8 * lane);
            const float wf[16] = {bf_lo(w0.x), bf_hi(w0.x), bf_lo(w0.y), bf_hi(w0.y), bf_lo(w0.z), bf_hi(w0.z), bf_lo(w0.w), bf_hi(w0.w),
                                  bf_lo(w1.x), bf_hi(w1.x), bf_lo(w1.y), bf_hi(w1.y), bf_lo(w1.z), bf_hi(w1.z), bf_lo(w1.w), bf_hi(w1.w)};
            const float* shb = mod + (size_t)l * NB * 6144 + (up ? 3072 : 0);
            float* dst = shw + (size_t)l * (NB * 6400) + (up ? NB * 2304 : 0);
            const int ldn = up ? 4096 : 2304;
#pragma unroll 2
            for (int b = 0; b < NB; ++b) {
                const float* sp = shb + (size_t)b * 6144;
                const f32x4 s0 = *(const f32x4*)(sp + 8 * lane), s1 = *(const f32x4*)(sp + 8 * lane + 4), s2 = *(const f32x4*)(sp + 512 + 8 * lane), s3 = *(const f32x4*)(sp + 512 + 8 * lane + 4);
                float a = (s0[0] * wf[0] + s0[1] * wf[1]) + (s0[2] * wf[2] + s0[3] * wf[3]) + (s1[0] * wf[4] + s1[1] * wf[5]) + (s1[2] * wf[6] + s1[3] * wf[7])
                        + (s2[0] * wf[8] + s2[1] * wf[9]) + (s2[2] * wf[10] + s2[3] * wf[11]) + (s3[0] * wf[12] + s3[1] * wf[13]) + (s3[2] * wf[14] + s3[3] * wf[15]);
                a = wave_sum(a);
                if (lane == 0) dst[(size_t)b * ldn + n] = a;
            }
        }
    }
    const int per = (TT + NGW - 1) / NGW;
    const int r0 = gw * per, r1 = (r0 + per < TT) ? r0 + per : TT;
    int curb = -1; f32x4 gs[4];
    for (int row = r0; row < r1; ++row) {
        int b, rb, S; row_info(row, b, rb, S);
        if (b != curb) { curb = b;
#pragma unroll
            for (int j = 0; j < 4; ++j) { const int c = 4 * lane + 256 * j; gs[j] = *(const f32x4*)(g + c) * (*(const f32x4*)(mod0 + (size_t)b * 6144 + 1024 + c) + 1.0f); } }
        const float* xr = (row < TP) ? xp + (size_t)row * DM : xs + (size_t)(row - TP) * DM;
        f32x4 v[4]; float s = 0.f;
#pragma unroll
        for (int j = 0; j < 4; ++j) { v[j] = *(const f32x4*)(xr + 4 * lane + 256 * j); s += (v[j].x * v[j].x + v[j].y * v[j].y) + (v[j].z * v[j].z + v[j].w * v[j].w); }
        s = wave_sum(s);
        if (lane == 0) rowsq0[row] = s;
        bf16_t* hr = H + (size_t)row * DM;
#pragma unroll
        for (int j = 0; j < 4; ++j) { const f32x4 o = v[j] * gs[j]; u32x2 w; w.x = pk_bf16(o.x, o.y); w.y = pk_bf16(o.z, o.w); *(u32x2*)(hr + 4 * lane + 256 * j) = w; }
    }
}
__device__ __forceinline__ void final_norm_phase(float* X, const bf16_t* H, const float* rowsq) {
    const int tid = opaque_tid(), lane = tid & 63, wave = tid >> 6;
    const int gw = blockIdx.x * NW + wave, NGW = gridDim.x * NW;
    const int per = (TT + NGW - 1) / NGW;
    const int r0 = gw * per, r1 = (r0 + per < TT) ? r0 + per : TT;
    for (int row = r0; row < r1; ++row) {
        float* xr = X + (size_t)row * DM; const bf16_t* hr = H + (size_t)row * DM;
        const float r = 1.0f / sqrtf(rowsq[row] * (1.0f / DM) + EPS);
#pragma unroll
        for (int j = 0; j < 2; ++j) { const u32x4 hv = *(const u32x4*)(hr + 8 * lane + 512 * j);
            *(f32x4*)(xr + 8 * lane + 512 * j) = (f32x4){bf_lo(hv.x), bf_hi(hv.x), bf_lo(hv.y), bf_hi(hv.y)} * r;
            *(f32x4*)(xr + 8 * lane + 512 * j + 4) = (f32x4){bf_lo(hv.z), bf_hi(hv.z), bf_lo(hv.w), bf_hi(hv.w)} * r; }
    }
}

constexpr int KSTR = 144, VSTR = 160, ATT_V_OFF = 256 * KSTR;
struct AttnCur { int qtok, f0, Ld; };
__device__ __forceinline__ void attn_load(const bf16_t* Z, int au, int d, int tid, u32x4 (&kr)[4], u32x4 (&vr)[4], bf16x8 (&qf)[2], AttnCur& c, int& hh) {
    const int lane = tid & 63, w = tid >> 6, fr = lane & 15, fq = lane >> 4;
    const int h = au & 7, blk = au >> 3;
    int b, rb, S; row_info(blk * 128, b, rb, S);
    const int lb = (blk * 128 - rb) >> 7, nfb = S / (128 * d);
    const int rho = lb / nfb, f0 = (lb % nfb) * 128, Ld = S / d;
#pragma unroll
    for (int it = 0; it < 4; ++it) {
        const int idx = tid + NTHR * it, row = idx >> 3, ch = idx & 7, fk = f0 - 64 + row;
        const bool ok = (fk >= 0) && (fk < Ld); const int fkc = ok ? fk : ((fk < 0) ? 0 : Ld - 1);
        const bf16_t* zr = Z + (size_t)(rb + fkc * d + rho) * PROJ + h * 64 + ch * 8;
        u32x4 kv = *(const u32x4*)(zr + 768), vv = *(const u32x4*)(zr + 1280);
        if (!ok) { kv = (u32x4){0u, 0u, 0u, 0u}; vv = (u32x4){0u, 0u, 0u, 0u}; }
        kr[it] = kv; vr[it] = vv;
    }
    c.qtok = rb + (f0 + 16 * w + fr) * d + rho; c.f0 = f0; c.Ld = Ld; hh = h;
#pragma unroll
    for (int kk = 0; kk < 2; ++kk) qf[kk] = *(const bf16x8*)(Z + (size_t)c.qtok * PROJ + 256 + h * 64 + 8 * fq + 32 * kk);
}
template <bool FINAL>
__device__ __forceinline__ void attn_phase1(LAS unsigned char* lds, const bf16_t* Z, int d, bf16_t* OP, f32x2* ML, const bf16_t* OP2, const bf16_t* OP3, const f32x2* ML2, const f32x2* ML3, bf16_t* Y) {
    const int tid = opaque_tid(), lane = tid & 63, w = tid >> 6, fr = lane & 15, fq = lane >> 4, G = gridDim.x;
    constexpr int NU = 6144;
    u32x4 kr[4], vr[4]; bf16x8 qn[2]; AttnCur cn; int hn;
    int au = blockIdx.x;
    if (au >= NU) return;
    attn_load(Z, au, d, tid, kr, vr, qn, cn, hn);
#define ATTN1_USE() asm volatile("" : "+v"(kr[0]), "+v"(kr[1]), "+v"(kr[2]), "+v"(kr[3]), "+v"(vr[0]), "+v"(vr[1]), "+v"(vr[2]), "+v"(vr[3]), "+v"(qn[0]), "+v"(qn[1]))
    ATTN1_USE();
    for (; au < NU; au += G) {
#pragma unroll
        for (int it = 0; it < 4; ++it) { const int idx = tid + NTHR * it, row = idx >> 3, ch = idx & 7;
            *(LAS u32x4*)(lds + row * KSTR + ch * 16) = kr[it]; *(LAS u32x4*)(lds + ATT_V_OFF + row * VSTR + ch * 16) = vr[it]; }
        const AttnCur c = cn; const int h = hn; bf16x8 qf[2] = {qn[0], qn[1]};
        __syncthreads();
        u32x2 o2[4], o3[4]; f32x2 a2, a3;
        if (FINAL) {
            a2 = ML2[(size_t)c.qtok * 8 + h]; a3 = ML3[(size_t)c.qtok * 8 + h];
            const bf16_t* p2 = OP2 + (size_t)c.qtok * 512 + h * 64 + 4 * fq; const bf16_t* p3 = OP3 + (size_t)c.qtok * 512 + h * 64 + 4 * fq;
#pragma unroll
            for (int dd = 0; dd < 4; ++dd) { o2[dd] = *(const u32x2*)(p2 + 16 * dd); o3[dd] = *(const u32x2*)(p3 + 16 * dd); }
        }
        { const int an = (au + G < NU) ? au + G : au; attn_load(Z, an, d, tid, kr, vr, qn, cn, hn); }
        f32x4 st[9];
        {
            bf16x8 kf[18];
#pragma unroll
            for (int t = 0; t < 9; ++t)
#pragma unroll
                for (int kk = 0; kk < 2; ++kk) kf[2 * t + kk] = *(const LAS bf16x8*)(lds + (16 * w + 16 * t + fr) * KSTR + (8 * fq + 32 * kk) * 2);
            asm volatile("s_waitcnt lgkmcnt(0)" ::: "memory");
            __builtin_amdgcn_sched_barrier(0);
#pragma unroll
            for (int t = 0; t < 9; ++t) { st[t] = mfma32(kf[2 * t], qf[0], (f32x4){0.f, 0.f, 0.f, 0.f}); }
#pragma unroll
            for (int t = 0; t < 9; ++t) { st[t] = mfma32(kf[2 * t + 1], qf[1], st[t]); }
        }
        const int tg = lane >> 4, tq = (lane >> 2) & 3, tp = lane & 3;
        const LAS unsigned char* vb = lds + ATT_V_OFF + (16 * w + 4 * tg + tq) * VSTR + tp * 8;
        bf16x4 vlo[2][4], vhi[2][4];
#pragma unroll
        for (int ks = 0; ks < 2; ++ks)
#pragma unroll
            for (int dd = 0; dd < 4; ++dd) { vlo[ks][dd] = tr4(vb + (32 * ks) * VSTR + dd * 32); vhi[ks][dd] = tr4(vb + (32 * ks + 16) * VSTR + dd * 32); }
        __builtin_amdgcn_sched_barrier(0);
        float mx = -1e30f;
        const int fkb = c.f0 + 16 * w - 64;
#pragma unroll
        for (int j = 0; j < 4; ++j) { if (4 * fq + j < fr) st[0][j] = -1e30f; if (4 * fq + j > fr) st[8][j] = -1e30f; }
        if ((fkb < 0) || (fkb + 144 > c.Ld)) {
#pragma unroll
            for (int t = 0; t < 9; ++t)
#pragma unroll
                for (int j = 0; j < 4; ++j) { const int fk = fkb + 16 * t + 4 * fq + j; if (fk < 0 || fk >= c.Ld) st[t][j] = -1e30f; }
        }
#pragma unroll
        for (int t = 0; t < 9; ++t) mx = fmaxf(mx, fmaxf(fmaxf(st[t][0], st[t][1]), fmaxf(st[t][2], st[t][3])));
        mx = fmaxf(mx, __shfl_xor(mx, 16)); mx = fmaxf(mx, __shfl_xor(mx, 32));
        float lsum = 0.f;
#pragma unroll
        for (int t = 0; t < 9; ++t)
#pragma unroll
            for (int j = 0; j < 4; ++j) { const float p = __builtin_amdgcn_exp2f(st[t][j] - mx); st[t][j] = p; lsum += p; }
        lsum += __shfl_xor(lsum, 16); lsum += __shfl_xor(lsum, 32);
        f32x4 ot[4];
#pragma unroll
        for (int dd = 0; dd < 4; ++dd) ot[dd] = (f32x4){0.f, 0.f, 0.f, 0.f};
        asm volatile("s_waitcnt lgkmcnt(0)" ::: "memory");
        __builtin_amdgcn_sched_barrier(0);
#pragma unroll
        for (int ks = 0; ks < 2; ++ks) {
            u32x4 pw; pw.x = pk_bf16(st[2 * ks][0], st[2 * ks][1]); pw.y = pk_bf16(st[2 * ks][2], st[2 * ks][3]); pw.z = pk_bf16(st[2 * ks + 1][0], st[2 * ks + 1][1]); pw.w = pk_bf16(st[2 * ks + 1][2], st[2 * ks + 1][3]);
            const bf16x8 pf = __builtin_bit_cast(bf16x8, pw);
#pragma unroll
            for (int dd = 0; dd < 4; ++dd) { const bf16x4 lo = vlo[ks][dd], hi = vhi[ks][dd];
                const bf16x8 vf = {lo[0], lo[1], lo[2], lo[3], hi[0], hi[1], hi[2], hi[3]}; ot[dd] = mfma32(vf, pf, ot[dd]); }
        }
        __builtin_amdgcn_sched_barrier(0);
        {
            bf16x4 wlo[2][4], whi[2][4], vl8[4];
#pragma unroll
            for (int ks = 0; ks < 2; ++ks)
#pragma unroll
                for (int dd = 0; dd < 4; ++dd) { wlo[ks][dd] = tr4(vb + (32 * (ks + 2)) * VSTR + dd * 32); whi[ks][dd] = tr4(vb + (32 * (ks + 2) + 16) * VSTR + dd * 32); }
#pragma unroll
            for (int dd = 0; dd < 4; ++dd) vl8[dd] = tr4(vb + 128 * VSTR + dd * 32);
            asm volatile("s_waitcnt lgkmcnt(0)" ::: "memory");
            __builtin_amdgcn_sched_barrier(0);
#pragma unroll
            for (int ks = 0; ks < 2; ++ks) {
                u32x4 pw; pw.x = pk_bf16(st[2 * ks + 4][0], st[2 * ks + 4][1]); pw.y = pk_bf16(st[2 * ks + 4][2], st[2 * ks + 4][3]); pw.z = pk_bf16(st[2 * ks + 5][0], st[2 * ks + 5][1]); pw.w = pk_bf16(st[2 * ks + 5][2], st[2 * ks + 5][3]);
                const bf16x8 pf = __builtin_bit_cast(bf16x8, pw);
#pragma unroll
                for (int dd = 0; dd < 4; ++dd) { const bf16x4 lo = wlo[ks][dd], hi = whi[ks][dd];
                    const bf16x8 vf = {lo[0], lo[1], lo[2], lo[3], hi[0], hi[1], hi[2], hi[3]}; ot[dd] = mfma32(vf, pf, ot[dd]); }
            }
            u32x2 pw; pw.x = pk_bf16(st[8][0], st[8][1]); pw.y = pk_bf16(st[8][2], st[8][3]);
            const bf16x4 pf = __builtin_bit_cast(bf16x4, pw);
#pragma unroll
            for (int dd = 0; dd < 4; ++dd) ot[dd] = mfma16(vl8[dd], pf, ot[dd]);
        }
        if (!FINAL) {
            const float inv = 1.0f / lsum;
            bf16_t* op = OP + (size_t)c.qtok * 512 + h * 64 + 4 * fq;
#pragma unroll
            for (int dd = 0; dd < 4; ++dd) { u32x2 o; o.x = pk_bf16(ot[dd][0] * inv, ot[dd][1] * inv); o.y = pk_bf16(ot[dd][2] * inv, ot[dd][3] * inv); *(u32x2*)(op + 16 * dd) = o; }
            if (fq == 0) ML[(size_t)c.qtok * 8 + h] = (f32x2){mx, lsum};
        } else {
            const float M = fmaxf(mx, fmaxf(a2.x, a3.x));
            const float w1 = __builtin_amdgcn_exp2f(mx - M), w2 = a2.y * __builtin_amdgcn_exp2f(a2.x - M), w3 = a3.y * __builtin_amdgcn_exp2f(a3.x - M);
            const float inv = 1.0f / (lsum * w1 + w2 + w3);
            const float c1 = w1 * inv, c2 = w2 * inv, c3 = w3 * inv;
            bf16_t* yp = Y + (size_t)c.qtok * DM + 256 + h * 64 + 4 * fq;
#pragma unroll
            for (int dd = 0; dd < 4; ++dd) {
                const float y0 = ot[dd][0] * c1 + bf_lo(o2[dd].x) * c2 + bf_lo(o3[dd].x) * c3, y1 = ot[dd][1] * c1 + bf_hi(o2[dd].x) * c2 + bf_hi(o3[dd].x) * c3;
                const float y2 = ot[dd][2] * c1 + bf_lo(o2[dd].y) * c2 + bf_lo(o3[dd].y) * c3, y3 = ot[dd][3] * c1 + bf_hi(o2[dd].y) * c2 + bf_hi(o3[dd].y) * c3;
                u32x2 o; o.x = pk_bf16(y0, y1); o.y = pk_bf16(y2, y3); *(u32x2*)(yp + 16 * dd) = o; }
        }
        ATTN1_USE();
        __syncthreads();
    }
#undef ATTN1_USE
}

template <bool FINAL>
__device__ __forceinline__ void attn_step(LAS unsigned char* lds, const bf16_t* Z, int d, bf16_t* OP, f32x2* ML, const bf16_t* OP2, const bf16_t* OP3, const f32x2* ML2, const f32x2* ML3, bf16_t* Y,
                                          int au, int G, int tid, u32x4 (&kr)[4], u32x4 (&vr)[4], bf16x8 (&qn)[2], AttnCur& cn, int& hn) {
    const int lane = tid & 63, w = tid >> 6, fr = lane & 15, fq = lane >> 4;
    constexpr int NU = 6144;
#pragma unroll
    for (int it = 0; it < 4; ++it) { const int idx = tid + NTHR * it, row = idx >> 3, ch = idx & 7;
        *(LAS u32x4*)(lds + row * KSTR + ch * 16) = kr[it]; *(LAS u32x4*)(lds + ATT_V_OFF + row * VSTR + ch * 16) = vr[it]; }
    const AttnCur c = cn; const int h = hn; bf16x8 qf[2] = {qn[0], qn[1]};
    __syncthreads();
    u32x2 o2[4], o3[4]; f32x2 a2, a3;
    if (FINAL) {
        const bf16_t* p2 = OP2 + (size_t)c.qtok * 512 + h * 64 + 4 * fq; const bf16_t* p3 = OP3 + (size_t)c.qtok * 512 + h * 64 + 4 * fq;
#pragma unroll
        for (int dd = 0; dd < 4; ++dd) { o2[dd] = *(const u32x2*)(p2 + 16 * dd); o3[dd] = *(const u32x2*)(p3 + 16 * dd); }
    }
    attn_load(Z, (au + 2 * G < NU) ? au + 2 * G : au, d, tid, kr, vr, qn, cn, hn);
    f32x4 st[9];
    {
        bf16x8 kf[9];
#pragma unroll
        for (int t = 0; t < 9; ++t) kf[t] = *(const LAS bf16x8*)(lds + (16 * w + 16 * t + fr) * KSTR + (8 * fq) * 2);
        asm volatile("s_waitcnt lgkmcnt(0)" ::: "memory");
        __builtin_amdgcn_sched_barrier(0);
#pragma unroll
        for (int t = 0; t < 9; ++t) { st[t] = mfma32(kf[t], qf[0], (f32x4){0.f, 0.f, 0.f, 0.f}); }
        __builtin_amdgcn_sched_barrier(0);
#pragma unroll
        for (int t = 0; t < 9; ++t) kf[t] = *(const LAS bf16x8*)(lds + (16 * w + 16 * t + fr) * KSTR + (8 * fq + 32) * 2);
        asm volatile("s_waitcnt lgkmcnt(0)" ::: "memory");
        __builtin_amdgcn_sched_barrier(0);
#pragma unroll
        for (int t = 0; t < 9; ++t) { st[t] = mfma32(kf[t], qf[1], st[t]); }
    }
    const int tg = lane >> 4, tq = (lane >> 2) & 3, tp = lane & 3;
    const LAS unsigned char* vb = lds + ATT_V_OFF + (16 * w + 4 * tg + tq) * VSTR + tp * 8;
    bf16x4 vlo[2][4], vhi[2][4];
#pragma unroll
    for (int ks = 0; ks < 2; ++ks)
#pragma unroll
        for (int dd = 0; dd < 4; ++dd) { vlo[ks][dd] = tr4(vb + (32 * ks) * VSTR + dd * 32); vhi[ks][dd] = tr4(vb + (32 * ks + 16) * VSTR + dd * 32); }
    __builtin_amdgcn_sched_barrier(0);
    float mx = -1e30f;
    const int fkb = c.f0 + 16 * w - 64;
#pragma unroll
    for (int j = 0; j < 4; ++j) { if (4 * fq + j < fr) st[0][j] = -1e30f; if (4 * fq + j > fr) st[8][j] = -1e30f; }
    if ((fkb < 0) || (fkb + 144 > c.Ld)) {
#pragma unroll
        for (int t = 0; t < 9; ++t)
#pragma unroll
            for (int j = 0; j < 4; ++j) { const int fk = fkb + 16 * t + 4 * fq + j; if (fk < 0 || fk >= c.Ld) st[t][j] = -1e30f; }
    }
#pragma unroll
    for (int t = 0; t < 9; ++t) mx = fmaxf(mx, fmaxf(fmaxf(st[t][0], st[t][1]), fmaxf(st[t][2], st[t][3])));
    mx = fmaxf(mx, __shfl_xor(mx, 16)); mx = fmaxf(mx, __shfl_xor(mx, 32));
    float lsum = 0.f;
#pragma unroll
    for (int t = 0; t < 9; ++t)
#pragma unroll
        for (int j = 0; j < 4; ++j) { const float p = __builtin_amdgcn_exp2f(st[t][j] - mx); st[t][j] = p; lsum += p; }
    lsum += __shfl_xor(lsum, 16); lsum += __shfl_xor(lsum, 32);
    f32x4 ot[4];
#pragma unroll
    for (int dd = 0; dd < 4; ++dd) ot[dd] = (f32x4){0.f, 0.f, 0.f, 0.f};
    asm volatile("s_waitcnt lgkmcnt(0)" ::: "memory");
    __builtin_amdgcn_sched_barrier(0);
#pragma unroll
    for (int ks = 0; ks < 2; ++ks) {
        u32x4 pw; pw.x = pk_bf16(st[2 * ks][0], st[2 * ks][1]); pw.y = pk_bf16(st[2 * ks][2], st[2 * ks][3]); pw.z = pk_bf16(st[2 * ks + 1][0], st[2 * ks + 1][1]); pw.w = pk_bf16(st[2 * ks + 1][2], st[2 * ks + 1][3]);
        const bf16x8 pf = __builtin_bit_cast(bf16x8, pw);
#pragma unroll
        for (int dd = 0; dd < 4; ++dd) { const bf16x4 lo = vlo[ks][dd], hi = vhi[ks][dd];
            const bf16x8 vf = {lo[0], lo[1], lo[2], lo[3], hi[0], hi[1], hi[2], hi[3]}; ot[dd] = mfma32(vf, pf, ot[dd]); }
    }
    __builtin_amdgcn_sched_barrier(0);
    {
        bf16x4 wlo[4], whi[4], vl8[4];
#pragma unroll
        for (int dd = 0; dd < 4; ++dd) { wlo[dd] = tr4(vb + (32 * 2) * VSTR + dd * 32); whi[dd] = tr4(vb + (32 * 2 + 16) * VSTR + dd * 32); }
#pragma unroll
        for (int dd = 0; dd < 4; ++dd) vl8[dd] = tr4(vb + 128 * VSTR + dd * 32);
        asm volatile("s_waitcnt lgkmcnt(0)" ::: "memory");
        __builtin_amdgcn_sched_barrier(0);
        {
            u32x4 pw; pw.x = pk_bf16(st[4][0], st[4][1]); pw.y = pk_bf16(st[4][2], st[4][3]); pw.z = pk_bf16(st[5][0], st[5][1]); pw.w = pk_bf16(st[5][2], st[5][3]);
            const bf16x8 pf = __builtin_bit_cast(bf16x8, pw);
#pragma unroll
            for (int dd = 0; dd < 4; ++dd) { const bf16x4 lo = wlo[dd], hi = whi[dd];
                const bf16x8 vf = {lo[0], lo[1], lo[2], lo[3], hi[0], hi[1], hi[2], hi[3]}; ot[dd] = mfma32(vf, pf, ot[dd]); }
            u32x2 pw2; pw2.x = pk_bf16(st[8][0], st[8][1]); pw2.y = pk_bf16(st[8][2], st[8][3]);
            const bf16x4 pf4 = __builtin_bit_cast(bf16x4, pw2);
#pragma unroll
            for (int dd = 0; dd < 4; ++dd) ot[dd] = mfma16(vl8[dd], pf4, ot[dd]);
        }
        __builtin_amdgcn_sched_barrier(0);
#pragma unroll
        for (int dd = 0; dd < 4; ++dd) { wlo[dd] = tr4(vb + (32 * 3) * VSTR + dd * 32); whi[dd] = tr4(vb + (32 * 3 + 16) * VSTR + dd * 32); }
        asm volatile("s_waitcnt lgkmcnt(0)" ::: "memory");
        __builtin_amdgcn_sched_barrier(0);
        {
            u32x4 pw; pw.x = pk_bf16(st[6][0], st[6][1]); pw.y = pk_bf16(st[6][2], st[6][3]); pw.z = pk_bf16(st[7][0], st[7][1]); pw.w = pk_bf16(st[7][2], st[7][3]);
            const bf16x8 pf = __builtin_bit_cast(bf16x8, pw);
#pragma unroll
            for (int dd = 0; dd < 4; ++dd) { const bf16x4 lo = wlo[dd], hi = whi[dd];
                const bf16x8 vf = {lo[0], lo[1], lo[2], lo[3], hi[0], hi[1], hi[2], hi[3]}; ot[dd] = mfma32(vf, pf, ot[dd]); }
        }
    }
    if (!FINAL) {
        const float inv = 1.0f / lsum;
        bf16_t* op = OP + (size_t)c.qtok * 512 + h * 64 + 4 * fq;
#pragma unroll
        for (int dd = 0; dd < 4; ++dd) { u32x2 o; o.x = pk_bf16(ot[dd][0] * inv, ot[dd][1] * inv); o.y = pk_bf16(ot[dd][2] * inv, ot[dd][3] * inv); *(u32x2*)(op + 16 * dd) = o; }
        if (fq == 0) ML[(size_t)c.qtok * 8 + h] = (f32x2){mx, lsum};
    } else {
        a2 = ML2[(size_t)c.qtok * 8 + h]; a3 = ML3[(size_t)c.qtok * 8 + h];
        const float M = fmaxf(mx, fmaxf(a2.x, a3.x));
        const float w1 = __builtin_amdgcn_exp2f(mx - M), w2 = a2.y * __builtin_amdgcn_exp2f(a2.x - M), w3 = a3.y * __builtin_amdgcn_exp2f(a3.x - M);
        const float inv = 1.0f / (lsum * w1 + w2 + w3);
        const float c1 = w1 * inv, c2 = w2 * inv, c3 = w3 * inv;
        bf16_t* yp = Y + (size_t)c.qtok * DM + 256 + h * 64 + 4 * fq;
#pragma unroll
        for (int dd = 0; dd < 4; ++dd) {
            const float y0 = ot[dd][0] * c1 + bf_lo(o2[dd].x) * c2 + bf_lo(o3[dd].x) * c3, y1 = ot[dd][1] * c1 + bf_hi(o2[dd].x) * c2 + bf_hi(o3[dd].x) * c3;
            const float y2 = ot[dd][2] * c1 + bf_lo(o2[dd].y) * c2 + bf_lo(o3[dd].y) * c3, y3 = ot[dd][3] * c1 + bf_hi(o2[dd].y) * c2 + bf_hi(o3[dd].y) * c3;
            u32x2 o; o.x = pk_bf16(y0, y1); o.y = pk_bf16(y2, y3); *(u32x2*)(yp + 16 * dd) = o; }
    }
    __syncthreads();
}
template <bool FINAL>
__device__ __forceinline__ void attn_phase(LAS unsigned char* lds, const bf16_t* Z, int d, bf16_t* OP, f32x2* ML, const bf16_t* OP2, const bf16_t* OP3, const f32x2* ML2, const f32x2* ML3, bf16_t* Y) {
    const int tid = opaque_tid(), G = gridDim.x;
    constexpr int NU = 6144;
    int au = blockIdx.x;
    if (au >= NU) return;
    u32x4 krA[4], vrA[4], krB[4], vrB[4]; bf16x8 qA[2], qB[2]; AttnCur cA, cB; int hA, hB;
    attn_load(Z, au, d, tid, krA, vrA, qA, cA, hA);
    attn_load(Z, (au + G < NU) ? au + G : au, d, tid, krB, vrB, qB, cB, hB);
    for (;;) {
        attn_step<FINAL>(lds, Z, d, OP, ML, OP2, OP3, ML2, ML3, Y, au, G, tid, krA, vrA, qA, cA, hA);
        au += G; if (au >= NU) break;
        attn_step<FINAL>(lds, Z, d, OP, ML, OP2, OP3, ML2, ML3, Y, au, G, tid, krB, vrB, qB, cB, hB);
        au += G; if (au >= NU) break;
    }
}
constexpr int A2_ROWS = 384, A2_V_OFF = A2_ROWS * KSTR;
struct Attn2Cur { int qtok0, f0, Ld, dstep, p16; };
__device__ __forceinline__ void attn2_load(const bf16_t* Z, int au, int d, int tid, u32x4 (&kr)[6], u32x4 (&vr)[6], Attn2Cur& c, int& hh) {
    const int lane = tid & 63, w = tid >> 6, fr = lane & 15, fq = lane >> 4;
    const int h = au & 7, v = au >> 3, reg = v >> 5, r = v & 31;
    int b, rb, S; row_info(reg * 4096, b, rb, S);
    const int rpos = reg * 4096 - rb;
    const int ld = (r < 16) ? 4 : 2; d = 1 << ld;
    const int rho = (r < 16) ? r : ((r - 16) >> 2);
    const int f0 = (rpos >> ld) + ((r < 16) ? 0 : ((r - 16) & 3) * 256), Ld = S >> ld;
#pragma unroll
    for (int it = 0; it < 6; ++it) {
        const int idx = tid + NTHR * it, row = idx >> 3, ch = idx & 7, fk = f0 - 64 + row;
        const bool ok = (fk >= 0) && (fk < Ld); const int fkc = ok ? fk : ((fk < 0) ? 0 : Ld - 1);
        const bf16_t* zr = Z + (size_t)(rb + fkc * d + rho) * PROJ + h * 64 + ch * 8;
        u32x4 kv = *(const u32x4*)(zr + 768), vv = *(const u32x4*)(zr + 1280);
        if (!ok) { kv = (u32x4){0u, 0u, 0u, 0u}; vv = (u32x4){0u, 0u, 0u, 0u}; }
        kr[it] = kv; vr[it] = vv;
    }
    c.qtok0 = rb + (f0 + 32 * w + fr) * d + rho; c.dstep = 16 * d; c.f0 = f0; c.Ld = Ld; c.p16 = (r < 16) ? 1 : 0; hh = h;
}
__device__ __forceinline__ void attn2_loadq(const bf16_t* Z, const Attn2Cur& c, int h, int fq, bf16x8 (&qf)[2][2]) {
#pragma unroll
    for (int qi = 0; qi < 2; ++qi)
#pragma unroll
        for (int kk = 0; kk < 2; ++kk) qf[qi][kk] = *(const bf16x8*)(Z + (size_t)(c.qtok0 + qi * c.dstep) * PROJ + 256 + h * 64 + 8 * fq + 32 * kk);
}
__device__ __forceinline__ void attn2_phase(LAS unsigned char* lds, const bf16_t* Z, bf16_t* OP16, f32x2* ML16, bf16_t* OP4, f32x2* ML4) {
    const int d = 0;
    const int tid = opaque_tid(), lane = tid & 63, w = tid >> 6, fr = lane & 15, fq = lane >> 4, G = gridDim.x;
    constexpr int NU = 24 * 32 * 8;
    u32x4 kr[6], vr[6]; bf16x8 qf[2][2]; Attn2Cur cn; int hn;
    int au = blockIdx.x;
    if (au >= NU) return;
    attn2_load(Z, au, d, tid, kr, vr, cn, hn);
    attn2_loadq(Z, cn, hn, fq, qf);
    for (; au < NU; au += G) {
#pragma unroll
        for (int it = 0; it < 6; ++it) { const int idx = tid + NTHR * it, row = idx >> 3, ch = idx & 7;
            *(LAS u32x4*)(lds + row * KSTR + ch * 16) = kr[it]; *(LAS u32x4*)(lds + A2_V_OFF + row * VSTR + ch * 16) = vr[it]; }
        const Attn2Cur c = cn; const int h = hn;
        __syncthreads();
        { const int an = (au + G < NU) ? au + G : au; attn2_load(Z, an, d, tid, kr, vr, cn, hn); }
        f32x4 st[2][9];
#pragma unroll
        for (int qi = 0; qi < 2; ++qi)
#pragma unroll
            for (int tt = 0; tt < 9; ++tt) st[qi][tt] = (f32x4){0.f, 0.f, 0.f, 0.f};
#pragma unroll
        for (int kk = 0; kk < 2; ++kk) {
#pragma unroll
            for (int kh = 0; kh < 2; ++kh) {
                bf16x8 kf[5];
#pragma unroll
                for (int i = 0; i < 5; ++i) kf[i] = *(const LAS bf16x8*)(lds + (32 * w + 16 * (5 * kh + i) + fr) * KSTR + (8 * fq + 32 * kk) * 2);
                asm volatile("s_waitcnt lgkmcnt(0)" ::: "memory");
                __builtin_amdgcn_sched_barrier(0);
#pragma unroll
                for (int i = 0; i < 5; ++i) { const int kt = 5 * kh + i;
                    if (kt < 9) st[0][kt] = mfma32(kf[i], qf[0][kk], st[0][kt]);
                    if (kt > 0) st[1][kt - 1] = mfma32(kf[i], qf[1][kk], st[1][kt - 1]);
                }
                __builtin_amdgcn_sched_barrier(0);
            }
        }
        attn2_loadq(Z, cn, hn, fq, qf);
        float mx[2], lsum[2];
        const int fkb = c.f0 + 32 * w - 64;
        const bool edge = (fkb < 0) || (fkb + 160 > c.Ld);
#pragma unroll
        for (int qi = 0; qi < 2; ++qi) {
            float m = -1e30f;
#pragma unroll
            for (int j = 0; j < 4; ++j) { if (4 * fq + j < fr) st[qi][0][j] = -1e30f; if (4 * fq + j > fr) st[qi][8][j] = -1e30f; }
            if (edge) {
#pragma unroll
                for (int tt = 0; tt < 9; ++tt)
#pragma unroll
                    for (int j = 0; j < 4; ++j) { const int fk = fkb + 16 * (qi + tt) + 4 * fq + j; if (fk < 0 || fk >= c.Ld) st[qi][tt][j] = -1e30f; }
            }
#pragma unroll
            for (int tt = 0; tt < 9; ++tt) m = fmaxf(m, fmaxf(fmaxf(st[qi][tt][0], st[qi][tt][1]), fmaxf(st[qi][tt][2], st[qi][tt][3])));
            m = fmaxf(m, __shfl_xor(m, 16)); m = fmaxf(m, __shfl_xor(m, 32));
            float l = 0.f;
#pragma unroll
            for (int tt = 0; tt < 9; ++tt)
#pragma unroll
                for (int j = 0; j < 4; ++j) { const float p = __builtin_amdgcn_exp2f(st[qi][tt][j] - m); st[qi][tt][j] = p; l += p; }
            l += __shfl_xor(l, 16); l += __shfl_xor(l, 32);
            mx[qi] = m; lsum[qi] = l;
            __builtin_amdgcn_sched_barrier(0);
        }
        u32x2 pp[2][9];
#pragma unroll
        for (int qi = 0; qi < 2; ++qi)
#pragma unroll
            for (int tt = 0; tt < 9; ++tt) { pp[qi][tt].x = pk_bf16(st[qi][tt][0], st[qi][tt][1]); pp[qi][tt].y = pk_bf16(st[qi][tt][2], st[qi][tt][3]); }
        __builtin_amdgcn_sched_barrier(0);
        f32x4 ot[2][4];
#pragma unroll
        for (int qi = 0; qi < 2; ++qi)
#pragma unroll
            for (int dd = 0; dd < 4; ++dd) ot[qi][dd] = (f32x4){0.f, 0.f, 0.f, 0.f};
        const int tg = lane >> 4, tq = (lane >> 2) & 3, tp = lane & 3;
        const LAS unsigned char* vb = lds + A2_V_OFF + (32 * w + 4 * tg + tq) * VSTR + tp * 8;
#pragma unroll
        for (int ks = 0; ks < 5; ++ks) {
            bf16x4 vlo[4], vhi[4];
#pragma unroll
            for (int dd = 0; dd < 4; ++dd) { vlo[dd] = tr4(vb + (32 * ks) * VSTR + dd * 32); vhi[dd] = tr4(vb + (32 * ks + 16) * VSTR + dd * 32); }
            u32x4 pw0, pw1;
            pw0.x = pp[0][2 * ks].x; pw0.y = pp[0][2 * ks].y;
            if (ks < 4) { pw0.z = pp[0][2 * ks + 1].x; pw0.w = pp[0][2 * ks + 1].y; } else { pw0.z = 0u; pw0.w = 0u; }
            if (ks > 0) { pw1.x = pp[1][2 * ks - 1].x; pw1.y = pp[1][2 * ks - 1].y; } else { pw1.x = 0u; pw1.y = 0u; }
            pw1.z = pp[1][2 * ks].x; pw1.w = pp[1][2 * ks].y;
            const bf16x8 pf0 = __builtin_bit_cast(bf16x8, pw0), pf1 = __builtin_bit_cast(bf16x8, pw1);
            asm volatile("s_waitcnt lgkmcnt(0)" ::: "memory");
            __builtin_amdgcn_sched_barrier(0);
#pragma unroll
            for (int dd = 0; dd < 4; ++dd) { const bf16x4 lo = vlo[dd], hi = vhi[dd];
                const bf16x8 vf = {lo[0], lo[1], lo[2], lo[3], hi[0], hi[1], hi[2], hi[3]};
                ot[0][dd] = mfma32(vf, pf0, ot[0][dd]); ot[1][dd] = mfma32(vf, pf1, ot[1][dd]); }
            __builtin_amdgcn_sched_barrier(0);
        }
#pragma unroll
        for (int qi = 0; qi < 2; ++qi) {
            const int qtok = c.qtok0 + qi * c.dstep;
            const float inv = 1.0f / lsum[qi];
            bf16_t* op = (c.p16 ? OP16 : OP4) + (size_t)qtok * 512 + h * 64 + 4 * fq;
#pragma unroll
            for (int dd = 0; dd < 4; ++dd) { u32x2 o; o.x = pk_bf16(ot[qi][dd][0] * inv, ot[qi][dd][1] * inv); o.y = pk_bf16(ot[qi][dd][2] * inv, ot[qi][dd][3] * inv); *(u32x2*)(op + 16 * dd) = o; }
            if (fq == 0) (c.p16 ? ML16 : ML4)[(size_t)qtok * 8 + h] = (f32x2){mx[qi], lsum[qi]};
        }
        __syncthreads();
    }
}

constexpr int PSTR = 528;
__device__ __forceinline__ void pool_load(const bf16_t* Z, int tile, int tid, u32x4 (&pr)[9]) {
    int b, rb, S; row_info(tile * 128, b, rb, S);
    const int p0 = tile * 128 - rb - 8;
#pragma unroll
    for (int it = 0; it < 9; ++it) { const int idx = tid + NTHR * it, row = idx >> 5, ch = idx & 31, j = p0 + row;
        const bool ok = (j >= 0) && (j < S); const int jc = ok ? j : ((j < 0) ? 0 : S - 1);
        u32x4 v = *(const u32x4*)(Z + (size_t)(rb + jc) * PROJ + ch * 8);
        if (!ok) v = (u32x4){0u, 0u, 0u, 0u};
        pr[it] = v; }
}
template <int G_>
__device__ __forceinline__ void pool_tiles(LAS unsigned char* lds, bf16_t* Y, const bf16x8 (&wf)[2][4], const f32x4 (&sc)[4], int S, int rb, int tile, int half, int fr, int fq) {
    constexpr int HW = 1 << G_;
#pragma unroll 1
    for (int mt = 0; mt < 4; ++mt) {
        const int tl = half * 64 + mt * 16 + fr, token = tile * 128 + tl, pos = token - rb;
        const int lo = (pos - HW > 0) ? pos - HW : 0, hi = (pos + HW < S) ? pos + HW : S;
        const float inv = 1.0f / (float)(hi - lo);
        f32x4 acc[4];
#pragma unroll
        for (int dd = 0; dd < 4; ++dd) acc[dd] = (f32x4){0.f, 0.f, 0.f, 0.f};
#pragma unroll
        for (int kk = 0; kk < 2; ++kk) {
            const LAS unsigned char* base = lds + (tl + 8 - HW) * PSTR + (G_ * 64 + 32 * kk + 8 * fq) * 2;
            float s[8];
#pragma unroll
            for (int i = 0; i < 8; ++i) s[i] = 0.f;
#pragma unroll
            for (int jj = 0; jj < 2 * HW; ++jj) {
                const u32x4 v = *(const LAS u32x4*)(base + jj * PSTR);
                s[0] += bf_lo(v.x); s[1] += bf_hi(v.x); s[2] += bf_lo(v.y); s[3] += bf_hi(v.y);
                s[4] += bf_lo(v.z); s[5] += bf_hi(v.z); s[6] += bf_lo(v.w); s[7] += bf_hi(v.w);
            }
            const u32x4 sv = *(const LAS u32x4*)(base + HW * PSTR);
            u32x4 pw;
            pw.x = pk_bf16(s[0] * inv - bf_lo(sv.x), s[1] * inv - bf_hi(sv.x)); pw.y = pk_bf16(s[2] * inv - bf_lo(sv.y), s[3] * inv - bf_hi(sv.y));
            pw.z = pk_bf16(s[4] * inv - bf_lo(sv.z), s[5] * inv - bf_hi(sv.z)); pw.w = pk_bf16(s[6] * inv - bf_lo(sv.w), s[7] * inv - bf_hi(sv.w));
            const bf16x8 pf = __builtin_bit_cast(bf16x8, pw);
#pragma unroll
            for (int dd = 0; dd < 4; ++dd) acc[dd] = mfma32(wf[kk][dd], pf, acc[dd]);
        }
#pragma unroll
        for (int dd = 0; dd < 4; ++dd) { const f32x4 o = acc[dd] * sc[dd];
            u32x2 ow; ow.x = pk_bf16(o.x, o.y); ow.y = pk_bf16(o.z, o.w); *(u32x2*)(Y + (size_t)token * DM + G_ * 64 + 16 * dd + 4 * fq) = ow; }
    }
}
__device__ __forceinline__ void pool_phase(LAS unsigned char* lds, const bf16_t* Z, bf16_t* Y, const bf16_t* pwt, const float* pscale) {
    const int tid = opaque_tid(), lane = tid & 63, w = __builtin_amdgcn_readfirstlane(tid >> 6), fr = lane & 15, fq = lane >> 4, G = gridDim.x;
    constexpr int NU = 768;
    int tile = blockIdx.x;
    if (tile >= NU) return;
    u32x4 pr[9];
    pool_load(Z, tile, tid, pr);
    const int g = w & 3, half = w >> 2;
    bf16x8 wf[2][4]; f32x4 sc[4];
#pragma unroll
    for (int kk = 0; kk < 2; ++kk)
#pragma unroll
        for (int dd = 0; dd < 4; ++dd) wf[kk][dd] = *(const bf16x8*)(pwt + (size_t)(g * 64 + 16 * dd + fr) * 64 + 32 * kk + 8 * fq);
#pragma unroll
    for (int dd = 0; dd < 4; ++dd) sc[dd] = *(const f32x4*)(pscale + g * 64 + 16 * dd + 4 * fq);
    for (; tile < NU; tile += G) {
#pragma unroll
        for (int it = 0; it < 9; ++it) { const int idx = tid + NTHR * it, row = idx >> 5, ch = idx & 31; *(LAS u32x4*)(lds + row * PSTR + ch * 16) = pr[it]; }
        __syncthreads();
        { const int tn = (tile + G < NU) ? tile + G : tile; pool_load(Z, tn, tid, pr); }
        int b, rb, S; row_info(tile * 128, b, rb, S);
        if (g == 0) pool_tiles<0>(lds, Y, wf, sc, S, rb, tile, half, fr, fq);
        else if (g == 1) pool_tiles<1>(lds, Y, wf, sc, S, rb, tile, half, fr, fq);
        else if (g == 2) pool_tiles<2>(lds, Y, wf, sc, S, rb, tile, half, fr, fq);
        else pool_tiles<3>(lds, Y, wf, sc, S, rb, tile, half, fr, fq);
        __syncthreads();
    }
}
__device__ __forceinline__ void sgu_load(const bf16_t* Z, int tile, int g, int tid, u32x4 (&vr)[2], u32x2 (&uv)[4]) {
    const int lane = tid & 63, w = tid >> 6, fr = lane & 15, fq = lane >> 4;
#pragma unroll
    for (int it = 0; it < 2; ++it) { const int idx = tid + NTHR * it, row = idx >> 3, ch = idx & 7; vr[it] = *(const u32x4*)(Z + (size_t)(tile * 128 + row) * PROJ + 2048 + g * 64 + ch * 8); }
#pragma unroll
    for (int cc = 0; cc < 4; ++cc) uv[cc] = *(const u32x2*)(Z + (size_t)(tile * 128 + 16 * w + fr) * PROJ + 1792 + g * 64 + 16 * cc + 4 * fq);
}
__device__ __forceinline__ void sgu_phase(LAS unsigned char* lds, const bf16_t* Z, bf16_t* Y, const bf16_t* sw, const float* sb) {
    const int tid = opaque_tid(), lane = tid & 63, w = tid >> 6, fr = lane & 15, fq = lane >> 4;
    const int G4 = gridDim.x >> 2;
    constexpr int NT = 768;
    const int g = blockIdx.x & 3;
    int tile = blockIdx.x >> 2;
    if ((int)blockIdx.x >= 4 * G4 || tile >= NT) return;
    u32x4 vr[2]; u32x2 un_uv[4];
    sgu_load(Z, tile, g, tid, vr, un_uv);
    u32x2 wlo[4], whi[4];
    { const bf16_t* wrow = sw + (size_t)(g * 128 + 16 * w + fr) * 128 + 4 * fq;
#pragma unroll
      for (int ks = 0; ks < 4; ++ks) { wlo[ks] = *(const u32x2*)(wrow + 32 * ks); whi[ks] = *(const u32x2*)(wrow + 32 * ks + 16); } }
    float bias = sb[g * 128 + 16 * w + fr];
    asm volatile("" : "+v"(vr[0]), "+v"(vr[1]), "+v"(un_uv[0]), "+v"(un_uv[1]), "+v"(un_uv[2]), "+v"(un_uv[3]));
    asm volatile("" : "+v"(wlo[0]), "+v"(wlo[1]), "+v"(wlo[2]), "+v"(wlo[3]), "+v"(whi[0]), "+v"(whi[1]), "+v"(whi[2]), "+v"(whi[3]), "+v"(bias));
    for (; tile < NT; tile += G4) {
        const int t0 = tile * 128;
#pragma unroll
        for (int it = 0; it < 2; ++it) {
            const int idx = tid + NTHR * it, row = idx >> 3, ch = idx & 7;
            const u32x4 v = vr[it];
            float x[8] = {bf_lo(v.x), bf_hi(v.x), bf_lo(v.y), bf_hi(v.y), bf_lo(v.z), bf_hi(v.z), bf_lo(v.w), bf_hi(v.w)};
            float s = ((x[0] + x[1]) + (x[2] + x[3])) + ((x[4] + x[5]) + (x[6] + x[7]));
            s += __shfl_xor(s, 1); s += __shfl_xor(s, 2); s += __shfl_xor(s, 4);
            const float mu = s * (1.0f / 64.0f);
            float q = 0.f;
#pragma unroll
            for (int i = 0; i < 8; ++i) { x[i] -= mu; q += x[i] * x[i]; }
            q += __shfl_xor(q, 1); q += __shfl_xor(q, 2); q += __shfl_xor(q, 4);
            const float rstd = 1.0f / sqrtf(q * (1.0f / 64.0f) + EPS);
            u32x4 o; o.x = pk_bf16(x[0] * rstd, x[1] * rstd); o.y = pk_bf16(x[2] * rstd, x[3] * rstd); o.z = pk_bf16(x[4] * rstd, x[5] * rstd); o.w = pk_bf16(x[6] * rstd, x[7] * rstd);
            *(LAS u32x4*)(lds + row * VSTR + ch * 16) = o;
        }
        __syncthreads();
        const int token = t0 + 16 * w + fr;
        u32x2 uv[4];
#pragma unroll
        for (int cc = 0; cc < 4; ++cc) uv[cc] = un_uv[cc];
        sgu_load(Z, (tile + G4 < NT) ? tile + G4 : tile, g, tid, vr, un_uv);
        f32x4 acc[4];
#pragma unroll
        for (int cc = 0; cc < 4; ++cc) acc[cc] = (f32x4){0.f, 0.f, 0.f, 0.f};
        const int tg = lane >> 4, tq = (lane >> 2) & 3, tp = lane & 3;
        const LAS unsigned char* vb = lds + (4 * tg + tq) * VSTR + tp * 8;
#pragma unroll
        for (int ks = 0; ks < 4; ++ks) {
            const u32x4 ww = {wlo[ks].x, wlo[ks].y, whi[ks].x, whi[ks].y};
            const bf16x8 wf = __builtin_bit_cast(bf16x8, ww);
#pragma unroll
            for (int cc = 0; cc < 4; ++cc) { const bf16x4 lo = tr4(vb + (32 * ks) * VSTR + cc * 32), hi = tr4(vb + (32 * ks + 16) * VSTR + cc * 32);
                const bf16x8 vf = {lo[0], lo[1], lo[2], lo[3], hi[0], hi[1], hi[2], hi[3]}; acc[cc] = mfma32(vf, wf, acc[cc]); }
        }
#pragma unroll
        for (int cc = 0; cc < 4; ++cc) {
            u32x2 o; o.x = pk_bf16((acc[cc][0] + bias) * bf_lo(uv[cc].x), (acc[cc][1] + bias) * bf_hi(uv[cc].x)); o.y = pk_bf16((acc[cc][2] + bias) * bf_lo(uv[cc].y), (acc[cc][3] + bias) * bf_hi(uv[cc].y));
            *(u32x2*)(Y + (size_t)token * DM + 768 + g * 64 + 16 * cc + 4 * fq) = o; }
        asm volatile("" : "+v"(vr[0]), "+v"(vr[1]), "+v"(un_uv[0]), "+v"(un_uv[1]), "+v"(un_uv[2]), "+v"(un_uv[3]));
        __syncthreads();
    }
}

constexpr int N_PHASES = 15;
__global__ void __launch_bounds__(NTHR, 2) fwd_kernel(Args A) {
    extern __shared__ __attribute__((aligned(16))) unsigned char lds_raw[];
    LAS unsigned char* lds = (LAS unsigned char*)lds_raw;
    cg::grid_group grid = cg::this_grid();
    unsigned char* ws = A.ws;
    const int G = gridDim.x;
    bf16_t* H = (bf16_t*)(ws + WS_H); bf16_t* Zb = (bf16_t*)(ws + WS_Z); bf16_t* Yb = (bf16_t*)(ws + WS_Y); bf16_t* Ub = (bf16_t*)(ws + WS_U);
    bf16_t* OP2 = (bf16_t*)A.out; bf16_t* OP3 = (bf16_t*)A.out + (size_t)TT * 512;
    f32x2* ML2 = (f32x2*)(ws + WS_ML2); f32x2* ML3 = (f32x2*)(ws + WS_ML3);
    const float* mod = (const float*)(ws + WS_MOD);
    const int lo = A.ph_lo, hi = A.ph_hi;
#ifndef PHMASK
#define PHMASK 0x1FF
#endif
#define PM(i) (((PHMASK) >> (i)) & 1)
#ifndef REP_N1
#define REP_N1 1
#endif
#ifndef REP_G1
#define REP_G1 1
#endif
#ifndef REP_MA
#define REP_MA 1
#endif
#ifndef REP_MB
#define REP_MB 1
#endif
#ifndef REP_G3
#define REP_G3 1
#endif
#define IN(k) (lo <= (k) && (k) < hi)
#define SEAM(k) do { if (IN(k) && IN((k) + 1)) grid.sync(); } while (0)
    if (PM(0) && IN(0)) { p0_prologue(A, lds); }
    SEAM(0);
    float* rowsq = (float*)(ws + WS_ROWSQ); float* shw = (float*)(ws + WS_SHW);
    if (PM(1) && IN(1)) prep_phase(A.x_p, A.x_s, A.g_mix, mod, H, rowsq, mod, (const bf16_t*)(ws + WS_WIN), (const bf16_t*)(ws + WS_WUP), shw);
    SEAM(1);
    for (int l = 0; l < 2; ++l) {
        const int pb = 2 + 6 * l;
        const float* modl = mod + (size_t)l * NB * 6144;
        const float* shwl = shw + (size_t)l * (NB * 6400);
        if (PM(2) && IN(pb + 0)) for (int rep = 0; rep < REP_G1; ++rep) {
            pg8::Gemm g{H, (const bf16_t*)(ws + WS_WIN) + (size_t)l * PROJ * DM, TT, PROJ, DM}; pg8::StaticOrder S; S.init(TT, PROJ, G, (int)blockIdx.x);
            pg8::EpiZ E{Zb, (const float*)(ws + WS_ROPE), rowsq + (size_t)(2 * l) * TT, shwl};
            pg8::gemm_phase<pg8::EpiZ, pg8::StaticOrder, true, true>(lds, g, S, E);
        }
        SEAM(pb + 0);
        if (PM(3) && IN(pb + 1)) for (int rep = 0; rep < REP_MA; ++rep) {
            const bf16_t* pwt = (const bf16_t*)(ws + WS_PWT) + (size_t)l * 4 * 4096; const bf16_t* sw = (const bf16_t*)(ws + WS_SGUW) + (size_t)l * 4 * 16384;
            attn2_phase(lds, Zb, OP3, ML3, OP2, ML2);
            sgu_phase(lds, Zb, Yb, sw, A.sgu_b + l * 512);
            pool_phase(lds, Zb, Yb, pwt, A.pool_scale + l * 256);
        }
        SEAM(pb + 1);
        if (PM(4) && IN(pb + 2)) for (int rep = 0; rep < REP_MB; ++rep) {
            attn_phase1<true>(lds, Zb, 1, nullptr, nullptr, OP2, OP3, ML2, ML3, Yb);
        }
        SEAM(pb + 2);
        if (PM(5) && IN(pb + 3)) {
            pg8::Gemm g{Yb, (const bf16_t*)(ws + WS_WOUT) + (size_t)l * DM * DM, TT, DM, DM}; pg8::StaticOrder S; S.init(TT, DM, G, (int)blockIdx.x);
            pg8::EpiRes E{A.x_p, A.x_s, H, A.g_mix + l * DM, modl + 1024, modl + 2048, H, A.g_mlp + l * DM, modl + 4096, rowsq + (size_t)(2 * l + 1) * TT};
            pg8::gemm_phase<pg8::EpiRes, pg8::StaticOrder, true, true>(lds, g, S, E);
        }
        SEAM(pb + 3);
        if (PM(6) && IN(pb + 4)) for (int rep = 0; rep < REP_G3; ++rep) {
            pg8::Gemm g{H, (const bf16_t*)(ws + WS_WUP) + (size_t)l * DFF * DM, TT, DFF, DM}; pg8::StaticOrder S; S.init(TT, DFF, G, (int)blockIdx.x);
            pg8::EpiRelu2 E{Ub, DFF, rowsq + (size_t)(2 * l + 1) * TT, shwl + NB * 2304};
            pg8::gemm_phase<pg8::EpiRelu2, pg8::StaticOrder, true, true>(lds, g, S, E);
        }
        SEAM(pb + 4);
        if (PM(7) && IN(pb + 5)) {
            pg8::Gemm g{Ub, (const bf16_t*)(ws + WS_WDOWN) + (size_t)l * DM * DFF, TT, DM, DFF}; pg8::StaticOrder S; S.init(TT, DM, G, (int)blockIdx.x, 1);
            pg8::EpiRes E{A.x_p, A.x_s, H, A.g_mlp + l * DM, modl + 4096, modl + 5120, H, (l == 0) ? A.g_mix + DM : A.g_final, (l == 0) ? mod + (size_t)NB * 6144 + 1024 : (const float*)nullptr, rowsq + (size_t)(2 * l + 2) * TT};
            pg8::gemm_phase<pg8::EpiRes, pg8::StaticOrder, true, true>(lds, g, S, E);
        }
        SEAM(pb + 5);
    }
    if (PM(8) && IN(14)) final_norm_phase(A.out, H, rowsq + (size_t)4 * TT);
#undef IN
#undef SEAM
}

#ifndef MK_SPLIT
#define MK_SPLIT 0
#endif
extern "C" void kernel_launch(void* const* d_in, const int* in_sizes, int n_in, void* d_out, int out_size, void* d_ws, size_t ws_size, hipStream_t stream) {
    static int grid = 0;
    if (grid == 0) {
        if (n_in != 17 || out_size != TT * DM || ws_size < WS_END) { fprintf(stderr, "kernel_launch: unexpected shapes: n_in %d out %d ws %zu\n", n_in, out_size, ws_size); grid = -1; return; }
        int dev = 0, cus = 0, per_cu = 0;
        hipGetDevice(&dev); hipDeviceGetAttribute(&cus, hipDeviceAttributeMultiprocessorCount, dev);
        if (hipFuncSetAttribute((const void*)fwd_kernel, hipFuncAttributeMaxDynamicSharedMemorySize, LDS_BYTES) != hipSuccess) { fprintf(stderr, "kernel_launch: hipFuncSetAttribute failed\n"); grid = -1; return; }
        if (hipOccupancyMaxActiveBlocksPerMultiprocessor(&per_cu, (const void*)fwd_kernel, NTHR, LDS_BYTES) != hipSuccess || per_cu < 1) { fprintf(stderr, "kernel_launch: occupancy query gave %d\n", per_cu); per_cu = 1; }
        (void)hipGetLastError();
        grid = cus * per_cu;
    }
    if (grid < 0) return;
    Args a{};
    a.x_p = (const float*)d_in[0]; a.x_s = (const float*)d_in[1]; a.c_p = (const float*)d_in[2]; a.c_s = (const float*)d_in[3]; a.w_ada = (const float*)d_in[4]; a.b_ada = (const float*)d_in[5];
    a.g_mix = (const float*)d_in[6]; a.g_mlp = (const float*)d_in[7]; a.w_in = (const float*)d_in[8]; a.pool_w = (const float*)d_in[9]; a.pool_scale = (const float*)d_in[10];
    a.sgu_w = (const float*)d_in[11]; a.sgu_b = (const float*)d_in[12]; a.w_out = (const float*)d_in[13]; a.w_up = (const float*)d_in[14]; a.w_down = (const float*)d_in[15]; a.g_final = (const float*)d_in[16];
    a.out = (float*)d_out; a.ws = (unsigned char*)d_ws;
#if MK_SPLIT
    for (int p = 0; p < N_PHASES; ++p) { a.ph_lo = p; a.ph_hi = p + 1; hipLaunchKernelGGL(fwd_kernel, dim3(grid), dim3(NTHR), LDS_BYTES, stream, a); }
#else
    a.ph_lo = 0; a.ph_hi = N_PHASES;
    void* args[] = {&a};
    hipError_t e = hipLaunchCooperativeKernel((const void*)fwd_kernel, dim3(grid), dim3(NTHR), args, LDS_BYTES, stream);
    if (e != hipSuccess) fprintf(stderr, "cooperative launch failed: %s (grid %d)\n", hipGetErrorString(e), grid);
#endif
}
```

```cpp
#include <hip/hip_runtime.h>
#include <hip/hip_cooperative_groups.h>
#include <cstdio>
#include <cstdint>
namespace cg = cooperative_groups;
__device__ __forceinline__ int opaque_tid() { int t = threadIdx.x; asm volatile("" : "+v"(t)); return t; }
namespace pg8 {
#define PG8_LAS __attribute__((address_space(3)))
typedef unsigned short bf16_t;
typedef short bf16x8 __attribute__((ext_vector_type(8)));
typedef float f32x4 __attribute__((ext_vector_type(4)));
typedef unsigned u32x4 __attribute__((ext_vector_type(4)));
constexpr int BM = 256, BK = 64, HALF = 128, HTB = HALF * BK * 2  , STAGE_BYTES = 8 * HTB, NXCD = 8, WGM = 8;

__host__ __device__ __forceinline__ int lds_byte(int r, int c) { const int st = (r >> 4) * 2 + (c >> 5), rr = r & 15, cc = c & 31, ob = rr * 64 + cc * 2; return st * 1024 + (ob ^ (((ob >> 9) & 1) << 5)); }
__host__ __device__ __forceinline__ void stage_rc(int b, int& R, int& C) { const int st = b / 1024, sb = b % 1024, swz = sb ^ (((sb >> 9) & 1) << 5); R = (st >> 1) * 16 + swz / 64; C = (st & 1) * 32 + (swz % 64) / 2; }
__host__ __device__ __forceinline__ int perm32(int rho) { const int n = rho >> 4, i = rho & 15; return 8 * (i >> 2) + 4 * n + (i & 3); }

struct Unit { int pm, pn; };
struct Gemm { const bf16_t* A; const bf16_t* Bt; int M, N, K; };

struct StaticOrder {
    int nM, nN, nwg, G, c, rev;
    __host__ __device__ void init(int M, int N, int G_, int c_, int rev_ = 0) { nM = M / BM; nN = N / BM; nwg = nM * nN; G = G_; c = c_; rev = rev_; }
    __host__ __device__ bool next(int i, Unit& u) const {
        const long L = (long)i * G + c; if (L >= nwg) return false;
        int wgid = (int)L; { const int q = nwg / NXCD, r = nwg % NXCD, xcd = wgid % NXCD; int off = wgid / NXCD; if (rev && r == 0) off = q - 1 - off; wgid = (xcd < r ? xcd * (q + 1) : r * (q + 1) + (xcd - r) * q) + off; }
        const int nig = WGM * nN, gid = wgid / nig, fm = gid * WGM, gsz = (nM - fm) < WGM ? (nM - fm) : WGM;
        u.pm = fm + ((wgid % nig) % gsz); u.pn = (wgid % nig) / gsz; return true;
    }
    __device__ __forceinline__ void a_ready(const Unit&) const {}
    __device__ __forceinline__ void done(const Unit&) const {}
};


typedef float f32x2 __attribute__((ext_vector_type(2)));
__device__ __forceinline__ unsigned cvt_pk_bf16(float lo, float hi) { typedef __bf16 b2 __attribute__((ext_vector_type(2))); f32x2 v = {lo, hi}; b2 b = __builtin_convertvector(v, b2); return __builtin_bit_cast(unsigned, b); }
__device__ __forceinline__ void tile_info(int pm, int& b, int& pos0) {
    if (pm < 128) { b = pm >> 6; pos0 = (pm & 63) << 8; } else { const int q = pm - 128; b = 2 + (q >> 5); pos0 = (q & 31) << 8; }
}
__device__ __forceinline__ float gelu_tanh(float x) {
    const float y = x * (1.0f + 0.044715f * x * x) * (2.0f * 0.7978845608028654f);
    const float e = __builtin_amdgcn_exp2f(-y * 1.4426950408889634f);
    return x * __builtin_amdgcn_rcpf(1.0f + e);
}
struct EpiZ {
    static constexpr bool PERM = true, AFTER_DRAIN = false;
    bf16_t* Z; const float* rope;
    const float* rowsq; const float* shw;
    __device__ __forceinline__ void operator()(const f32x4 (&acc)[2][2][4][2], const Unit& u, int wr, int wc, int fr_, int fq) const {
        int fr = fr_; asm volatile("" : "+v"(fr));
        int b, pos0; tile_info(u.pm, b, pos0);
        const int pn = u.pn;
        const bool rot = (pn >= 1 && pn <= 4) && ((wc & 1) == 0);
        const bool gel = (pn >= 7);
        const float qs = (pn == 1 || pn == 2) ? 0.125f * 1.4426950408889634f : 1.0f;
        const int row0 = u.pm * BM + wr * 64 + fr;
        const int col0 = pn * BM + wc * 32 + 8 * fq;
        f32x4 sv[2][2];
#pragma unroll
        for (int bj = 0; bj < 2; ++bj)
#pragma unroll
            for (int n = 0; n < 2; ++n) sv[bj][n] = *(const f32x4*)(shw + (size_t)b * 2304 + col0 + bj * HALF + 4 * n);
#pragma unroll
        for (int ai = 0; ai < 2; ++ai)
#pragma unroll
            for (int m = 0; m < 4; ++m) {
                const int rl = ai * HALF + m * 16;
                bf16_t* rowp = Z + (size_t)(row0 + rl) * 2304 + col0;
                const float rr = 1.0f / sqrtf(rowsq[row0 + rl] * (1.0f / 1024.0f) + 1e-6f);
                f32x4 cs[4];
                if (rot) { const f32x4* rp = (const f32x4*)(rope + (size_t)(pos0 + wr * 64 + fr + rl) * 16);
#pragma unroll
                    for (int i = 0; i < 4; ++i) cs[i] = rp[i]; }
#pragma unroll
                for (int bj = 0; bj < 2; ++bj) {
                    f32x4 v0 = acc[ai][bj][m][0] * rr + sv[bj][0], v1 = acc[ai][bj][m][1] * rr + sv[bj][1];
                    if (rot) {
                        f32x4 p0, p1;
#pragma unroll
                        for (int j = 0; j < 4; ++j) { p0[j] = __shfl_xor(v0[j], 16); p1[j] = __shfl_xor(v1[j], 16); }
                        const float sg = (fq == 0) ? -1.0f : 1.0f;
                        if (fq < 2) {
                            f32x4 r0, r1;
                            r0[0] = v0[0] * cs[0][0] + sg * p0[0] * cs[0][1]; r0[1] = v0[1] * cs[0][2] + sg * p0[1] * cs[0][3];
                            r0[2] = v0[2] * cs[1][0] + sg * p0[2] * cs[1][1]; r0[3] = v0[3] * cs[1][2] + sg * p0[3] * cs[1][3];
                            r1[0] = v1[0] * cs[2][0] + sg * p1[0] * cs[2][1]; r1[1] = v1[1] * cs[2][2] + sg * p1[1] * cs[2][3];
                            r1[2] = v1[2] * cs[3][0] + sg * p1[2] * cs[3][1]; r1[3] = v1[3] * cs[3][2] + sg * p1[3] * cs[3][3];
                            v0 = r0; v1 = r1;
                        }
                    }
                    if (gel) {
#pragma unroll
                        for (int j = 0; j < 4; ++j) { v0[j] = gelu_tanh(v0[j]); v1[j] = gelu_tanh(v1[j]); }
                    }
                    v0 = v0 * qs; v1 = v1 * qs;
                    u32x4 w; w.x = cvt_pk_bf16(v0[0], v0[1]); w.y = cvt_pk_bf16(v0[2], v0[3]); w.z = cvt_pk_bf16(v1[0], v1[1]); w.w = cvt_pk_bf16(v1[2], v1[3]);
                    *(u32x4*)(rowp + bj * HALF) = w;
                }
            }
    }
};
struct EpiRelu2 {
    static constexpr bool PERM = true, AFTER_DRAIN = false;
    bf16_t* O; int ldc; const float* rowsq; const float* shw;
    __device__ __forceinline__ void operator()(const f32x4 (&acc)[2][2][4][2], const Unit& u, int wr, int wc, int fr_, int fq) const {
        int fr = fr_; asm volatile("" : "+v"(fr));
        int b, pos0; tile_info(u.pm, b, pos0);
        const int row0 = u.pm * BM + wr * 64 + fr; const int col0 = u.pn * BM + wc * 32 + 8 * fq;
        f32x4 sv[2][2];
#pragma unroll
        for (int bj = 0; bj < 2; ++bj)
#pragma unroll
            for (int n = 0; n < 2; ++n) sv[bj][n] = *(const f32x4*)(shw + (size_t)b * 4096 + col0 + bj * HALF + 4 * n);
#pragma unroll
        for (int ai = 0; ai < 2; ++ai)
#pragma unroll
            for (int m = 0; m < 4; ++m) { bf16_t* rowp = O + (size_t)(row0 + ai * HALF + m * 16) * ldc + col0;
                const float rr = 1.0f / sqrtf(rowsq[row0 + ai * HALF + m * 16] * (1.0f / 1024.0f) + 1e-6f);
#pragma unroll
                for (int bj = 0; bj < 2; ++bj) { f32x4 v0 = acc[ai][bj][m][0] * rr + sv[bj][0], v1 = acc[ai][bj][m][1] * rr + sv[bj][1];
#pragma unroll
                    for (int j = 0; j < 4; ++j) { const float a = fmaxf(v0[j], 0.f), c = fmaxf(v1[j], 0.f); v0[j] = a * a; v1[j] = c * c; }
                    u32x4 w; w.x = cvt_pk_bf16(v0[0], v0[1]); w.y = cvt_pk_bf16(v0[2], v0[3]); w.z = cvt_pk_bf16(v1[0], v1[1]); w.w = cvt_pk_bf16(v1[2], v1[3]);
                    *(u32x4*)(rowp + bj * HALF) = w; } }
    }
};
struct EpiRes {
    static constexpr bool PERM = true, AFTER_DRAIN = false;
    const float* xin_p; const float* xin_s;
    const bf16_t* Hin; const float* gin; const float* scin;
    const float* gate;
    bf16_t* Hn; const float* gn; const float* scn;
    float* rowsq;
    __device__ __forceinline__ void operator()(const f32x4 (&acc)[2][2][4][2], const Unit& u, int wr, int wc, int fr_, int fq) const {
        int fr = fr_; asm volatile("" : "+v"(fr));
        int b, pos0; tile_info(u.pm, b, pos0);
        const float* base = (u.pm < 128) ? xin_p + (size_t)(u.pm * BM) * 1024 : xin_s + (size_t)(u.pm * BM - 32768) * 1024;
        const size_t hrow = (size_t)(u.pm * BM) * 1024;
        const int col0 = u.pn * BM + wc * 32 + 8 * fq;
        float ss[8];
#pragma unroll
        for (int i = 0; i < 8; ++i) ss[i] = 0.f;
#pragma unroll
        for (int bj = 0; bj < 2; ++bj) {
            const int c = col0 + bj * HALF;
            f32x4 gv[2], gs[2], gi[2];
#pragma unroll
            for (int n = 0; n < 2; ++n) {
                gv[n] = *(const f32x4*)(gate + (size_t)b * 6144 + c + 4 * n);
                gs[n] = *(const f32x4*)(gn + c + 4 * n);
                if (scn) gs[n] = gs[n] * (*(const f32x4*)(scn + (size_t)b * 6144 + c + 4 * n) + 1.0f);
                gi[n] = (f32x4){1.f, 1.f, 1.f, 1.f};
                if (Hin) { const f32x4 t = *(const f32x4*)(gin + c + 4 * n) * (*(const f32x4*)(scin + (size_t)b * 6144 + c + 4 * n) + 1.0f);
                    gi[n] = (f32x4){1.0f / t[0], 1.0f / t[1], 1.0f / t[2], 1.0f / t[3]}; }
            }
#pragma unroll
            for (int ai = 0; ai < 2; ++ai)
#pragma unroll
                for (int m = 0; m < 4; ++m) { const int rl = ai * HALF + wr * 64 + m * 16 + fr; const size_t off = (size_t)rl * 1024 + c;
                    f32x4 x0, x1;
                    if (Hin) { const u32x4 hv = *(const u32x4*)(Hin + hrow + off);
                        x0 = (f32x4){__uint_as_float(hv.x << 16), __uint_as_float(hv.x & 0xffff0000u), __uint_as_float(hv.y << 16), __uint_as_float(hv.y & 0xffff0000u)} * gi[0];
                        x1 = (f32x4){__uint_as_float(hv.z << 16), __uint_as_float(hv.z & 0xffff0000u), __uint_as_float(hv.w << 16), __uint_as_float(hv.w & 0xffff0000u)} * gi[1]; }
                    else { x0 = *(const f32x4*)(base + off); x1 = *(const f32x4*)(base + off + 4); }
                    const f32x4 o0 = x0 + gv[0] * acc[ai][bj][m][0], o1 = x1 + gv[1] * acc[ai][bj][m][1];
                    ss[ai * 4 + m] += (o0[0] * o0[0] + o0[1] * o0[1]) + (o0[2] * o0[2] + o0[3] * o0[3]) + (o1[0] * o1[0] + o1[1] * o1[1]) + (o1[2] * o1[2] + o1[3] * o1[3]);
                    const f32x4 h0 = o0 * gs[0], h1 = o1 * gs[1];
                    u32x4 w; w.x = cvt_pk_bf16(h0[0], h0[1]); w.y = cvt_pk_bf16(h0[2], h0[3]); w.z = cvt_pk_bf16(h1[0], h1[1]); w.w = cvt_pk_bf16(h1[2], h1[3]);
                    *(u32x4*)(Hn + hrow + off) = w;
                }
            asm volatile("" ::: "memory");
        }
#pragma unroll
        for (int ai = 0; ai < 2; ++ai)
#pragma unroll
            for (int m = 0; m < 4; ++m) { float s = ss[ai * 4 + m]; s += __shfl_xor(s, 16); s += __shfl_xor(s, 32);
                if (fq == 0) __hip_atomic_fetch_add(rowsq + u.pm * BM + ai * HALF + wr * 64 + m * 16 + fr, s, __ATOMIC_RELAXED, __HIP_MEMORY_SCOPE_AGENT); }
    }
};

template <class Epi, class Sched, bool ALIGN_EPI = false, bool SP2 = false>
__device__ __forceinline__ void gemm_phase(PG8_LAS unsigned char* lds, const Gemm g, const Sched& S, const Epi& E) {
    const int tid = opaque_tid(), wid = __builtin_amdgcn_readfirstlane(tid >> 6), lane = tid & 63, wr = wid >> 2, wc = wid & 3, fr = lane & 15, fq = lane >> 4;
    const int K = g.K, nt = K / BK;
    unsigned voffA[2], voffB[2];
#pragma unroll
    for (int i = 0; i < 2; ++i) { int R, C; stage_rc(tid * 16 + i * 8192, R, C); const int Rb = Epi::PERM ? ((R & ~31) + perm32(R & 31)) : R;
        voffA[i] = (unsigned)(R * K + C) * 2u; voffB[i] = (unsigned)(Rb * K + C) * 2u; }
    const size_t kstep = (size_t)(BK * 2);
    const size_t hstep = (size_t)HALF * K * 2;
    const size_t tstep = 2 * hstep;
    const unsigned ldsw = (unsigned)wid * 1024u;
    const int aoff = lds_byte(wr * 64 + fr, fq * 8), boff = lds_byte(wc * 32 + fr, fq * 8);
#define PG8_SA(b, h) (((b) * 2 + (h)) * HTB)
#define PG8_SB(b, h) ((4 + (b) * 2 + (h)) * HTB)
#define PG8_STAGE(bufoff, gbase, voff) do { _Pragma("unroll") for (int _i = 0; _i < 2; ++_i) \
        __builtin_amdgcn_global_load_lds((const unsigned*)((const char*)(gbase) + (voff)[_i]), (PG8_LAS unsigned*)(lds + (bufoff) + ldsw + _i * 8192), 16, 0, 0); } while (0)
#define PG8_LDA(dst, b, h) do { _Pragma("unroll") for (int m = 0; m < 4; ++m) _Pragma("unroll") for (int k = 0; k < 2; ++k) dst[m][k] = *(const PG8_LAS bf16x8*)(lds + PG8_SA(b, h) + aoff + m * 2048 + k * 1024); } while (0)
#define PG8_LDB(dst, b, h) do { _Pragma("unroll") for (int n = 0; n < 2; ++n) _Pragma("unroll") for (int k = 0; k < 2; ++k) dst[n][k] = *(const PG8_LAS bf16x8*)(lds + PG8_SB(b, h) + boff + n * 2048 + k * 1024); } while (0)
#define PG8_MMA(ai, bj, At, Bt) do { __builtin_amdgcn_s_setprio(1); _Pragma("unroll") for (int m = 0; m < 4; ++m) _Pragma("unroll") for (int n = 0; n < 2; ++n) _Pragma("unroll") for (int k = 0; k < 2; ++k) \
        acc[ai][bj][m][n] = __builtin_amdgcn_mfma_f32_16x16x32_bf16(Bt[n][k], At[m][k], acc[ai][bj][m][n], 0, 0, 0); __builtin_amdgcn_s_setprio(0); } while (0)
#define PG8_WAIT_V(n) asm volatile("s_waitcnt vmcnt(" #n ")" ::: "memory")
#define PG8_WAIT_L(n) asm volatile("s_waitcnt lgkmcnt(" #n ")" ::: "memory")
#define PG8_BAR __builtin_amdgcn_s_barrier()
#define PG8_SCHED __builtin_amdgcn_sched_barrier(0)
    Unit cur, nxt; int ui = 0;
    if (!S.next(0, cur)) return;
    f32x4 acc[2][2][4][2];
#pragma unroll
    for (int a = 0; a < 2; ++a)
#pragma unroll
        for (int b = 0; b < 2; ++b)
#pragma unroll
            for (int m = 0; m < 4; ++m)
#pragma unroll
                for (int n = 0; n < 2; ++n) acc[a][b][m][n] = (f32x4){0.f, 0.f, 0.f, 0.f};
    bf16x8 At[4][2], B0[2][2], B1[2][2];
    const char* cA = (const char*)g.A + (size_t)cur.pm * tstep; const char* cB = (const char*)g.Bt + (size_t)cur.pn * tstep;
    S.a_ready(cur);
    if constexpr (SP2) {
        PG8_STAGE(PG8_SB(0, 0), cB, voffB); PG8_STAGE(PG8_SB(0, 1), cB + hstep, voffB); PG8_STAGE(PG8_SA(0, 0), cA, voffA); PG8_STAGE(PG8_SA(0, 1), cA + hstep, voffA);
        if (wr == 1) PG8_BAR;
        PG8_WAIT_V(2); PG8_BAR;
        PG8_STAGE(PG8_SB(1, 0), cB + kstep, voffB); PG8_STAGE(PG8_SA(1, 0), cA + kstep, voffA); PG8_STAGE(PG8_SB(1, 1), cB + hstep + kstep, voffB);
        PG8_WAIT_V(6); PG8_BAR;
    } else {
        PG8_STAGE(PG8_SB(0, 0), cB, voffB); PG8_STAGE(PG8_SA(0, 0), cA, voffA); PG8_STAGE(PG8_SB(0, 1), cB + hstep, voffB); PG8_STAGE(PG8_SA(0, 1), cA + hstep, voffA);
        if (wr == 1) PG8_BAR;
        PG8_WAIT_V(4); PG8_BAR;
        PG8_STAGE(PG8_SB(1, 0), cB + kstep, voffB); PG8_STAGE(PG8_SA(1, 0), cA + kstep, voffA); PG8_STAGE(PG8_SB(1, 1), cB + hstep + kstep, voffB);
        PG8_WAIT_V(6); PG8_BAR;
    }
    for (;;) {
        const bool has_next = S.next(ui + 1, nxt);
        const char* nA = has_next ? (const char*)g.A + (size_t)nxt.pm * tstep : cA; const char* nB = has_next ? (const char*)g.Bt + (size_t)nxt.pn * tstep : cB;
        for (int t = 0; t < nt; t += 2) {
            const bool last = (t == nt - 2);
            const char* a1 = cA + (size_t)(t + 1) * kstep;
            const char* a2 = last ? nA : cA + (size_t)(t + 2) * kstep; const char* b2 = last ? nB : cB + (size_t)(t + 2) * kstep;
            const char* a3 = a2 + kstep; const char* b3 = b2 + kstep;
            if (last && has_next) S.a_ready(nxt);
            if constexpr (SP2) {
            PG8_LDB(B0, 0, 0); PG8_LDB(B1, 0, 1); PG8_SCHED; PG8_LDA(At, 0, 0); PG8_STAGE(PG8_SA(1, 1), a1 + hstep, voffA);
            PG8_WAIT_V(8); PG8_WAIT_L(0); PG8_BAR; PG8_MMA(0, 0, At, B0); PG8_MMA(0, 1, At, B1); PG8_BAR; PG8_SCHED;
            PG8_LDA(At, 0, 1); PG8_STAGE(PG8_SB(0, 0), b2, voffB); PG8_STAGE(PG8_SB(0, 1), b2 + hstep, voffB); PG8_STAGE(PG8_SA(0, 0), a2, voffA);
            PG8_WAIT_V(8); PG8_WAIT_L(0); PG8_BAR; PG8_MMA(1, 0, At, B0); PG8_MMA(1, 1, At, B1); PG8_BAR; PG8_SCHED;
            PG8_LDB(B0, 1, 0); PG8_LDB(B1, 1, 1); PG8_SCHED; PG8_LDA(At, 1, 0); PG8_STAGE(PG8_SA(0, 1), a2 + hstep, voffA);
            PG8_WAIT_V(8); PG8_WAIT_L(0); PG8_BAR; PG8_MMA(0, 0, At, B0); PG8_MMA(0, 1, At, B1); PG8_BAR; PG8_SCHED;
            PG8_LDA(At, 1, 1); PG8_STAGE(PG8_SB(1, 0), b3, voffB); PG8_STAGE(PG8_SB(1, 1), b3 + hstep, voffB); PG8_STAGE(PG8_SA(1, 0), a3, voffA);
            PG8_WAIT_V(8); PG8_WAIT_L(0); PG8_BAR; PG8_MMA(1, 0, At, B0); PG8_MMA(1, 1, At, B1); PG8_BAR; PG8_SCHED;
            } else {
            PG8_LDB(B0, 0, 0); PG8_SCHED; PG8_LDA(At, 0, 0); PG8_STAGE(PG8_SA(1, 1), a1 + hstep, voffA);
            PG8_WAIT_L(8); PG8_BAR; PG8_WAIT_L(0); PG8_MMA(0, 0, At, B0); PG8_BAR; PG8_SCHED;
            PG8_LDB(B1, 0, 1); PG8_STAGE(PG8_SB(0, 0), b2, voffB);
            PG8_BAR; PG8_WAIT_L(0); PG8_MMA(0, 1, At, B1); PG8_BAR;
            PG8_LDA(At, 0, 1); PG8_STAGE(PG8_SA(0, 0), a2, voffA);
            PG8_BAR; PG8_WAIT_L(0); PG8_MMA(1, 0, At, B0); PG8_BAR; PG8_SCHED;
            PG8_STAGE(PG8_SB(0, 1), b2 + hstep, voffB);
            PG8_WAIT_V(6); PG8_BAR; PG8_MMA(1, 1, At, B1); PG8_BAR;
            PG8_LDB(B0, 1, 0); PG8_SCHED; PG8_LDA(At, 1, 0); PG8_STAGE(PG8_SA(0, 1), a2 + hstep, voffA);
            PG8_WAIT_L(8); PG8_BAR; PG8_WAIT_L(0); PG8_MMA(0, 0, At, B0); PG8_BAR; PG8_SCHED;
            PG8_LDB(B1, 1, 1); PG8_STAGE(PG8_SB(1, 0), b3, voffB);
            PG8_BAR; PG8_WAIT_L(0); PG8_MMA(0, 1, At, B1); PG8_BAR;
            PG8_LDA(At, 1, 1); PG8_STAGE(PG8_SA(1, 0), a3, voffA);
            PG8_BAR; PG8_WAIT_L(0); PG8_MMA(1, 0, At, B0); PG8_BAR; PG8_SCHED;
            PG8_STAGE(PG8_SB(1, 1), b3 + hstep, voffB);
            PG8_WAIT_V(6); PG8_BAR; PG8_MMA(1, 1, At, B1); PG8_BAR;
            }
        }
        if constexpr (ALIGN_EPI) { if (wr == 0) PG8_BAR; }
        if constexpr (!Epi::AFTER_DRAIN) { E(acc, cur, wr, wc, fr, fq); S.done(cur); }
        if (!has_next) break;
#pragma unroll
        for (int a = 0; a < 2; ++a)
#pragma unroll
            for (int b = 0; b < 2; ++b)
#pragma unroll
                for (int m = 0; m < 4; ++m)
#pragma unroll
                    for (int n = 0; n < 2; ++n) acc[a][b][m][n] = (f32x4){0.f, 0.f, 0.f, 0.f};
        cur = nxt; cA = nA; cB = nB; ++ui;
        if constexpr (ALIGN_EPI) { if (wr == 1) PG8_BAR; }
    }
    PG8_WAIT_V(0);
    if constexpr (!ALIGN_EPI) { if (wr == 0) PG8_BAR; }
    PG8_BAR;
    if constexpr (Epi::AFTER_DRAIN) { E.fused(acc, cur, wr, wc, fr, fq, lds, wid, lane); S.done(cur); }
#undef PG8_SA
#undef PG8_SB
#undef PG8_STAGE
#undef PG8_LDA
#undef PG8_LDB
#undef PG8_MMA
#undef PG8_WAIT_V
#undef PG8_WAIT_L
#undef PG8_BAR
#undef PG8_SCHED
}
}

#define LAS __attribute__((address_space(3)))
typedef unsigned short bf16_t;
typedef short bf16x8 __attribute__((ext_vector_type(8)));
typedef short bf16x4 __attribute__((ext_vector_type(4)));
typedef float f32x4 __attribute__((ext_vector_type(4)));
typedef float f32x2 __attribute__((ext_vector_type(2)));
typedef unsigned u32x4 __attribute__((ext_vector_type(4)));
typedef unsigned u32x2 __attribute__((ext_vector_type(2)));
typedef short v4i16_t __attribute__((ext_vector_type(4)));

constexpr int NW = 8, NTHR = 512;
constexpr int DM = 1024, TP = 32768, TT = 98304, PROJ = 2304, DFF = 4096, NB = 10;
constexpr float EPS = 1e-6f;
constexpr size_t MiB = 1u << 20;
constexpr size_t WS_WIN = 0, WS_WOUT = 9 * MiB, WS_WUP = 13 * MiB, WS_WDOWN = 29 * MiB;
constexpr size_t WS_MOD = 45 * MiB, WS_ROPE = 46 * MiB, WS_PWT = 47 * MiB, WS_SGUW = 47 * MiB + 512 * 1024;
constexpr size_t WS_ML2 = 48 * MiB, WS_ML3 = 54 * MiB;
constexpr size_t WS_SHW = 45 * MiB + 512 * 1024;
constexpr size_t WS_ROWSQ = 61 * MiB;
constexpr size_t WS_H = 64 * MiB, WS_OP2 = 64 * MiB, WS_OP3 = 160 * MiB;
constexpr size_t WS_U = 256 * MiB, WS_Z = 256 * MiB, WS_Y = 688 * MiB, WS_END = 1024 * MiB;
constexpr int LDS_BYTES = 147456;

struct Args {
    const float *x_p, *x_s, *c_p, *c_s, *w_ada, *b_ada, *g_mix, *g_mlp, *w_in, *pool_w, *pool_scale, *sgu_w, *sgu_b, *w_out, *w_up, *w_down, *g_final;
    float* out; unsigned char* ws; int ph_lo, ph_hi;
};

__device__ __forceinline__ unsigned pk_bf16(float lo, float hi) { return pg8::cvt_pk_bf16(lo, hi); }
__device__ __forceinline__ float bf_lo(unsigned w) { return __uint_as_float(w << 16); }
__device__ __forceinline__ float bf_hi(unsigned w) { return __uint_as_float(w & 0xffff0000u); }
__device__ __forceinline__ bf16x4 tr4(const LAS unsigned char* p) { return __builtin_bit_cast(bf16x4, __builtin_amdgcn_ds_read_tr16_b64_v4i16((LAS v4i16_t*)p)); }
__device__ __forceinline__ f32x4 mfma32(bf16x8 a, bf16x8 b, f32x4 c) { return __builtin_amdgcn_mfma_f32_16x16x32_bf16(a, b, c, 0, 0, 0); }
__device__ __forceinline__ f32x4 mfma16(bf16x4 a, bf16x4 b, f32x4 c) { return __builtin_amdgcn_mfma_f32_16x16x16bf16_1k(a, b, c, 0, 0, 0); }
__device__ __forceinline__ float wave_sum(float v) {
#pragma unroll
    for (int o = 1; o < 64; o <<= 1) v += __shfl_xor(v, o);
    return v;
}
__device__ __forceinline__ void row_info(int row, int& b, int& rb, int& S) {
    if (row < TP) { b = row >> 14; rb = b << 14; S = 16384; } else { const int q = (row - TP) >> 13; b = 2 + q; rb = TP + (q << 13); S = 8192; }
}

__device__ __forceinline__ unsigned f2bf(float f) { unsigned u = __builtin_bit_cast(unsigned, f); return (u + 0x7fffu + ((u >> 16) & 1u)) >> 16; }
__device__ __forceinline__ unsigned pk2(float lo, float hi) { return f2bf(lo) | (f2bf(hi) << 16); }
__device__ __forceinline__ void p0_transpose_item(const float* W, int K, int N, bf16_t* WT, LAS float* scr, int item, int lane) {
    const int nblk = N / 32, kb = item / nblk, nb = item % nblk, k0 = 64 * kb, n0 = 32 * nb;
#pragma unroll 8
    for (int i = 0; i < 32; ++i) { const int kk = 2 * i + (lane >> 5); scr[kk * 33 + (lane & 31)] = W[(size_t)(k0 + kk) * N + n0 + (lane & 31)]; }
    asm volatile("s_waitcnt lgkmcnt(0)" ::: "memory");
    const int c = lane & 7;
#pragma unroll
    for (int j = 0; j < 4; ++j) { const int n = (lane >> 3) + 8 * j; const LAS float* s = scr + (8 * c) * 33 + n;
        u32x4 o; o.x = pk2(s[0 * 33], s[1 * 33]); o.y = pk2(s[2 * 33], s[3 * 33]); o.z = pk2(s[4 * 33], s[5 * 33]); o.w = pk2(s[6 * 33], s[7 * 33]);
        *(u32x4*)(WT + (size_t)(n0 + n) * K + k0 + 8 * c) = o; }
    asm volatile("s_waitcnt lgkmcnt(0)" ::: "memory");
}
__device__ __forceinline__ void p0_prologue(const Args& A, LAS unsigned char* lds) {
    const int tid = opaque_tid(), lane = tid & 63, wave = tid >> 6, G = gridDim.x;
    unsigned char* ws = A.ws;
    {
        LAS float* cact = (LAS float*)lds;
        LAS float* red = (LAS float*)(lds + 40960);
        float* mod = (float*)(ws + WS_MOD);
        bool have = false;
        for (int it = blockIdx.x; it < 192; it += G) {
            if (!have) {
                for (int i = tid; i < NB * DM; i += NTHR) { const int b = i >> 10, k = i & 1023; const float c = (b < 2) ? A.c_p[b * DM + k] : A.c_s[(b - 2) * DM + k];
                    cact[i] = c / (1.0f + __expf(-c)); }
                have = true;
            }
            __syncthreads();
            const int l = it / 96, c0 = (it % 96) * 64, col = c0 + lane, kg = wave;
            float acc[NB];
#pragma unroll
            for (int b = 0; b < NB; ++b) acc[b] = 0.f;
            const float* wp = A.w_ada + ((size_t)l * DM + kg * 128) * 6144 + col;
#pragma unroll 4
            for (int k = 0; k < 128; ++k) { const float w = wp[(size_t)k * 6144];
#pragma unroll
                for (int b = 0; b < NB; ++b) acc[b] += cact[b * DM + kg * 128 + k] * w; }
#pragma unroll
            for (int b = 0; b < NB; ++b) red[(kg * NB + b) * 64 + lane] = acc[b];
            __syncthreads();
            for (int i = tid; i < NB * 64; i += NTHR) { const int b = i >> 6, cc = i & 63; float s = A.b_ada[(size_t)l * 6144 + c0 + cc];
#pragma unroll
                for (int g = 0; g < 8; ++g) s += red[(g * NB + b) * 64 + cc];
                mod[((size_t)l * NB + b) * 6144 + c0 + cc] = s; }
        }
        __syncthreads();
    }
    {
        LAS float* scr = (LAS float*)(lds + wave * 16384);
        const int gw = blockIdx.x * NW + wave, NGW = G * NW;
        constexpr int I_IN = (DM / 64) * (PROJ / 32), I_OUT = (DM / 64) * (DM / 32), I_UP = (DM / 64) * (DFF / 32), I_DN = (DFF / 64) * (DM / 32);
        constexpr int PER_L = I_IN + I_OUT + I_UP + I_DN;
        for (int it = gw; it < 2 * PER_L; it += NGW) {
            const int l = it / PER_L; int r = it % PER_L;
            if (r < I_IN) { p0_transpose_item(A.w_in + (size_t)l * DM * PROJ, DM, PROJ, (bf16_t*)(ws + WS_WIN) + (size_t)l * PROJ * DM, scr, r, lane); continue; } r -= I_IN;
            if (r < I_OUT) { p0_transpose_item(A.w_out + (size_t)l * DM * DM, DM, DM, (bf16_t*)(ws + WS_WOUT) + (size_t)l * DM * DM, scr, r, lane); continue; } r -= I_OUT;
            if (r < I_UP) { p0_transpose_item(A.w_up + (size_t)l * DM * DFF, DM, DFF, (bf16_t*)(ws + WS_WUP) + (size_t)l * DFF * DM, scr, r, lane); continue; } r -= I_UP;
            p0_transpose_item(A.w_down + (size_t)l * DFF * DM, DFF, DM, (bf16_t*)(ws + WS_WDOWN) + (size_t)l * DM * DFF, scr, r, lane);
        }
    }
    const int gt = blockIdx.x * NTHR + tid, NGT = G * NTHR;
    {
        float* rope = (float*)(ws + WS_ROPE);
        for (int e = gt; e < 16384 * 8; e += NGT) {
            const int pos = e >> 3, i = e & 7;
            float fi = 1.0f;
            fi = (i == 1) ? 0.1939227432012558f : fi; fi = (i == 2) ? 0.03760603070259094f : fi; fi = (i == 3) ? 0.007292664609849453f : fi; fi = (i == 4) ? 0.0014142135623842478f : fi;
            fi = (i == 5) ? 0.00027424818836152554f : fi; fi = (i == 6) ? 5.318296098266728e-05f : fi; fi = (i == 7) ? 1.0313386155758053e-05f : fi;
            const float angf = (float)pos * fi;
            const double ang = (double)angf;
            const double TWO_PI = 6.283185307179586476925286766559;
            const double r = ang - TWO_PI * rint(ang / TWO_PI);
            const double r2 = r * r;
            double sn = 0.0, cn = 0.0, ts = r, tc = 1.0;
#pragma unroll 1
            for (int k = 0; k < 14; ++k) { sn += ts; cn += tc; tc = -tc * r2 / (double)((2 * k + 1) * (2 * k + 2)); ts = -ts * r2 / (double)((2 * k + 2) * (2 * k + 3)); }
            rope[2 * e] = (float)cn; rope[2 * e + 1] = (float)sn;
        }
    }
    { float* rz = (float*)(ws + WS_ROWSQ) + TT; for (int e = gt; e < 4 * TT; e += NGT) rz[e] = 0.f; }
    {
        bf16_t* pwt = (bf16_t*)(ws + WS_PWT);
        for (int e = gt; e < 2 * 4 * 64 * 64; e += NGT) { const int c = e & 63, d = (e >> 6) & 63, lg = e >> 12; pwt[e] = (bf16_t)f2bf(A.pool_w[(size_t)lg * 4096 + c * 64 + d]); }
        bf16_t* sw = (bf16_t*)(ws + WS_SGUW);
        for (int e = gt; e < 2 * 4 * 128 * 128; e += NGT) sw[e] = (bf16_t)f2bf(A.sgu_w[e]);
    }
}

__device__ __forceinline__ void prep_phase(const float* xp, const float* xs, const float* g, const float* mod0, bf16_t* H, float* rowsq0, const float* mod, const bf16_t* win_t, const bf16_t* wup_t, float* shw) {
    const int tid = opaque_tid(), lane = tid & 63, wave = tid >> 6;
    const int gw = blockIdx.x * NW + wave, NGW = gridDim.x * NW;
    {
        for (int t = gw; t < 2 * 6400; t += NGW) {
            const int l = t / 6400, r = t - l * 6400; const bool up = (r >= 2304); const int n = up ? r - 2304 : r;
            const bf16_t* wrow = (up ? wup_t + (size_t)l * DFF * DM : win_t + (size_t)l * PROJ * DM) + (size_t)n * DM;
            const u32x4 w0 = *(const u32x4*)(wrow + 8 * lane), w1 = *(const u32x4*)(wrow + 512 + 8 * lane);
            const float wf[16] = {bf_lo(w0.x), bf_hi(w0.x), bf_lo(w0.y), bf_hi(w0.y), bf_lo(w0.z), bf_hi(w0.z), bf_lo(w0.w), bf_hi(w0.w),
                                  bf_lo(w1.x), bf_hi(w1.x), bf_lo(w1.y), bf_hi(w1.y), bf_lo(w1.z), bf_hi(w1.z), bf_lo(w1.w), bf_hi(w1.w)};
            const float* shb = mod + (size_t)l * NB * 6144 + (up ? 3072 : 0);
            float* dst = shw + (size_t)l * (NB * 6400) + (up ? NB * 2304 : 0);
            const int ldn = up ? 4096 : 2304;
#pragma unroll 2
            for (int b = 0; b < NB; ++b) {
                const float* sp = shb + (size_t)b * 6144;
                const f32x4 s0 = *(const f32x4*)(sp + 8 * lane), s1 = *(const f32x4*)(sp + 8 * lane + 4), s2 = *(const f32x4*)(sp + 512 + 8 * lane), s3 = *(const f32x4*)(sp + 512 + 8 * lane + 4);
                float a = (s0[0] * wf[0] + s0[1] * wf[1]) + (s0[2] * wf[2] + s0[3] * wf[3]) + (s1[0] * wf[4] + s1[1] * wf[5]) + (s1[2] * wf[6] + s1[3] * wf[7])
                        + (s2[0] * wf[8] + s2[1] * wf[9]) + (s2[2] * wf[10] + s2[3] * wf[11]) + (s3[0] * wf[12] + s3[1] * wf[13]) + (s3[2] * wf[14] + s3[3] * wf[15]);
                a = wave_sum(a);
                if (lane == 0) dst[(size_t)b * ldn + n] = a;
            }
        }
    }
    const int per = (TT + NGW - 1) / NGW;
    const int r0 = gw * per, r1 = (r0 + per < TT) ? r0 + per : TT;
    int curb = -1; f32x4 gs[4];
    for (int row = r0; row < r1; ++row) {
        int b, rb, S; row_info(row, b, rb, S);
        if (b != curb) { curb = b;
#pragma unroll
            for (int j = 0; j < 4; ++j) { const int c = 4 * lane + 256 * j; gs[j] = *(const f32x4*)(g + c) * (*(const f32x4*)(mod0 + (size_t)b * 6144 + 1024 + c) + 1.0f); } }
        const float* xr = (row < TP) ? xp + (size_t)row * DM : xs + (size_t)(row - TP) * DM;
        f32x4 v[4]; float s = 0.f;
#pragma unroll
        for (int j = 0; j < 4; ++j) { v[j] = *(const f32x4*)(xr + 4 * lane + 256 * j); s += (v[j].x * v[j].x + v[j].y * v[j].y) + (v[j].z * v[j].z + v[j].w * v[j].w); }
        s = wave_sum(s);
        if (lane == 0) rowsq0[row] = s;
        bf16_t* hr = H + (size_t)row * DM;
#pragma unroll
        for (int j = 0; j < 4; ++j) { const f32x4 o = v[j] * gs[j]; u32x2 w; w.x = pk_bf16(o.x, o.y); w.y = pk_bf16(o.z, o.w); *(u32x2*)(hr + 4 * lane + 256 * j) = w; }
    }
}
__device__ __forceinline__ void final_norm_phase(float* X, const bf16_t* H, const float* rowsq) {
    const int tid = opaque_tid(), lane = tid & 63, wave = tid >> 6;
    const int gw = blockIdx.x * NW + wave, NGW = gridDim.x * NW;
    const int per = (TT + NGW - 1) / NGW;
    const int r0 = gw * per, r1 = (r0 + per < TT) ? r0 + per : TT;
    for (int row = r0; row < r1; ++row) {
        float* xr = X + (size_t)row * DM; const bf16_t* hr = H + (size_t)row * DM;
        const float r = 1.0f / sqrtf(rowsq[row] * (1.0f / DM) + EPS);
#pragma unroll
        for (int j = 0; j < 2; ++j) { const u32x4 hv = *(const u32x4*)(hr + 8 * lane + 512 * j);
            *(f32x4*)(xr + 8 * lane + 512 * j) = (f32x4){bf_lo(hv.x), bf_hi(hv.x), bf_lo(hv.y), bf_hi(hv.y)} * r;
            *(f32x4*)(xr + 8 * lane + 512 * j + 4) = (f32x4){bf_lo(hv.z), bf_hi(hv.z), bf_lo(hv.w), bf_hi(hv.w)} * r; }
    }
}

constexpr int KSTR = 144, VSTR = 160, ATT_V_OFF = 256 * KSTR;
struct AttnCur { int qtok, f0, Ld; };
__device__ __forceinline__ void attn_load(const bf16_t* Z, int au, int d, int tid, u32x4 (&kr)[4], u32x4 (&vr)[4], bf16x8 (&qf)[2], AttnCur& c, int& hh) {
    const int lane = tid & 63, w = tid >> 6, fr = lane & 15, fq = lane >> 4;
    const int h = au & 7, blk = au >> 3;
    int b, rb, S; row_info(blk * 128, b, rb, S);
    const int lb = (blk * 128 - rb) >> 7, nfb = S / (128 * d);
    const int rho = lb / nfb, f0 = (lb % nfb) * 128, Ld = S / d;
#pragma unroll
    for (int it = 0; it < 4; ++it) {
        const int idx = tid + NTHR * it, row = idx >> 3, ch = idx & 7, fk = f0 - 64 + row;
        u32x4 kv = {0u, 0u, 0u, 0u}, vv = {0u, 0u, 0u, 0u};
        if (fk >= 0 && fk < Ld) { const bf16_t* zr = Z + (size_t)(rb + fk * d + rho) * PROJ + h * 64 + ch * 8; kv = *(const u32x4*)(zr + 768); vv = *(const u32x4*)(zr + 1280); }
        kr[it] = kv; vr[it] = vv;
    }
    c.qtok = rb + (f0 + 16 * w + fr) * d + rho; c.f0 = f0; c.Ld = Ld; hh = h;
#pragma unroll
    for (int kk = 0; kk < 2; ++kk) qf[kk] = *(const bf16x8*)(Z + (size_t)c.qtok * PROJ + 256 + h * 64 + 8 * fq + 32 * kk);
}
template <bool FINAL>
__device__ __forceinline__ void attn_phase1(LAS unsigned char* lds, const bf16_t* Z, int d, bf16_t* OP, f32x2* ML, const bf16_t* OP2, const bf16_t* OP3, const f32x2* ML2, const f32x2* ML3, bf16_t* Y) {
    const int tid = opaque_tid(), lane = tid & 63, w = tid >> 6, fr = lane & 15, fq = lane >> 4, G = gridDim.x;
    constexpr int NU = 6144;
    u32x4 kr[4], vr[4]; bf16x8 qn[2]; AttnCur cn; int hn;
    int au = blockIdx.x;
    if (au >= NU) return;
    attn_load(Z, au, d, tid, kr, vr, qn, cn, hn);
    for (; au < NU; au += G) {
#pragma unroll
        for (int it = 0; it < 4; ++it) { const int idx = tid + NTHR * it, row = idx >> 3, ch = idx & 7;
            *(LAS u32x4*)(lds + row * KSTR + ch * 16) = kr[it]; *(LAS u32x4*)(lds + ATT_V_OFF + row * VSTR + ch * 16) = vr[it]; }
        const AttnCur c = cn; const int h = hn; bf16x8 qf[2] = {qn[0], qn[1]};
        __syncthreads();
        u32x2 o2[4], o3[4]; f32x2 a2, a3;
        if (FINAL) {
            a2 = ML2[(size_t)c.qtok * 8 + h]; a3 = ML3[(size_t)c.qtok * 8 + h];
            const bf16_t* p2 = OP2 + (size_t)c.qtok * 512 + h * 64 + 4 * fq; const bf16_t* p3 = OP3 + (size_t)c.qtok * 512 + h * 64 + 4 * fq;
#pragma unroll
            for (int dd = 0; dd < 4; ++dd) { o2[dd] = *(const u32x2*)(p2 + 16 * dd); o3[dd] = *(const u32x2*)(p3 + 16 * dd); }
        }
        { const int an = (au + G < NU) ? au + G : au; attn_load(Z, an, d, tid, kr, vr, qn, cn, hn); }
        f32x4 st[9];
        {
            bf16x8 kf[18];
#pragma unroll
            for (int t = 0; t < 9; ++t)
#pragma unroll
                for (int kk = 0; kk < 2; ++kk) kf[2 * t + kk] = *(const LAS bf16x8*)(lds + (16 * w + 16 * t + fr) * KSTR + (8 * fq + 32 * kk) * 2);
            asm volatile("s_waitcnt lgkmcnt(0)" ::: "memory");
            __builtin_amdgcn_sched_barrier(0);
#pragma unroll
            for (int t = 0; t < 9; ++t) { st[t] = mfma32(kf[2 * t], qf[0], (f32x4){0.f, 0.f, 0.f, 0.f}); }
#pragma unroll
            for (int t = 0; t < 9; ++t) { st[t] = mfma32(kf[2 * t + 1], qf[1], st[t]); }
        }
        const int tg = lane >> 4, tq = (lane >> 2) & 3, tp = lane & 3;
        const LAS unsigned char* vb = lds + ATT_V_OFF + (16 * w + 4 * tg + tq) * VSTR + tp * 8;
        bf16x4 vlo[2][4], vhi[2][4];
#pragma unroll
        for (int ks = 0; ks < 2; ++ks)
#pragma unroll
            for (int dd = 0; dd < 4; ++dd) { vlo[ks][dd] = tr4(vb + (32 * ks) * VSTR + dd * 32); vhi[ks][dd] = tr4(vb + (32 * ks + 16) * VSTR + dd * 32); }
        __builtin_amdgcn_sched_barrier(0);
        float mx = -1e30f;
        const int fkb = c.f0 + 16 * w - 64;
#pragma unroll
        for (int j = 0; j < 4; ++j) { if (4 * fq + j < fr) st[0][j] = -1e30f; if (4 * fq + j > fr) st[8][j] = -1e30f; }
        if ((fkb < 0) || (fkb + 144 > c.Ld)) {
#pragma unroll
            for (int t = 0; t < 9; ++t)
#pragma unroll
                for (int j = 0; j < 4; ++j) { const int fk = fkb + 16 * t + 4 * fq + j; if (fk < 0 || fk >= c.Ld) st[t][j] = -1e30f; }
        }
#pragma unroll
        for (int t = 0; t < 9; ++t) mx = fmaxf(mx, fmaxf(fmaxf(st[t][0], st[t][1]), fmaxf(st[t][2], st[t][3])));
        mx = fmaxf(mx, __shfl_xor(mx, 16)); mx = fmaxf(mx, __shfl_xor(mx, 32));
        float lsum = 0.f;
#pragma unroll
        for (int t = 0; t < 9; ++t)
#pragma unroll
            for (int j = 0; j < 4; ++j) { const float p = __builtin_amdgcn_exp2f(st[t][j] - mx); st[t][j] = p; lsum += p; }
        lsum += __shfl_xor(lsum, 16); lsum += __shfl_xor(lsum, 32);
        f32x4 ot[4];
#pragma unroll
        for (int dd = 0; dd < 4; ++dd) ot[dd] = (f32x4){0.f, 0.f, 0.f, 0.f};
        asm volatile("s_waitcnt lgkmcnt(0)" ::: "memory");
        __builtin_amdgcn_sched_barrier(0);
#pragma unroll
        for (int ks = 0; ks < 2; ++ks) {
            u32x4 pw; pw.x = pk_bf16(st[2 * ks][0], st[2 * ks][1]); pw.y = pk_bf16(st[2 * ks][2], st[2 * ks][3]); pw.z = pk_bf16(st[2 * ks + 1][0], st[2 * ks + 1][1]); pw.w = pk_bf16(st[2 * ks + 1][2], st[2 * ks + 1][3]);
            const bf16x8 pf = __builtin_bit_cast(bf16x8, pw);
#pragma unroll
            for (int dd = 0; dd < 4; ++dd) { const bf16x4 lo = vlo[ks][dd], hi = vhi[ks][dd];
                const bf16x8 vf = {lo[0], lo[1], lo[2], lo[3], hi[0], hi[1], hi[2], hi[3]}; ot[dd] = mfma32(vf, pf, ot[dd]); }
        }
        __builtin_amdgcn_sched_barrier(0);
        {
            bf16x4 wlo[2][4], whi[2][4], vl8[4];
#pragma unroll
            for (int ks = 0; ks < 2; ++ks)
#pragma unroll
                for (int dd = 0; dd < 4; ++dd) { wlo[ks][dd] = tr4(vb + (32 * (ks + 2)) * VSTR + dd * 32); whi[ks][dd] = tr4(vb + (32 * (ks + 2) + 16) * VSTR + dd * 32); }
#pragma unroll
            for (int dd = 0; dd < 4; ++dd) vl8[dd] = tr4(vb + 128 * VSTR + dd * 32);
            asm volatile("s_waitcnt lgkmcnt(0)" ::: "memory");
            __builtin_amdgcn_sched_barrier(0);
#pragma unroll
            for (int ks = 0; ks < 2; ++ks) {
                u32x4 pw; pw.x = pk_bf16(st[2 * ks + 4][0], st[2 * ks + 4][1]); pw.y = pk_bf16(st[2 * ks + 4][2], st[2 * ks + 4][3]); pw.z = pk_bf16(st[2 * ks + 5][0], st[2 * ks + 5][1]); pw.w = pk_bf16(st[2 * ks + 5][2], st[2 * ks + 5][3]);
                const bf16x8 pf = __builtin_bit_cast(bf16x8, pw);
#pragma unroll
                for (int dd = 0; dd < 4; ++dd) { const bf16x4 lo = wlo[ks][dd], hi = whi[ks][dd];
                    const bf16x8 vf = {lo[0], lo[1], lo[2], lo[3], hi[0], hi[1], hi[2], hi[3]}; ot[dd] = mfma32(vf, pf, ot[dd]); }
            }
            u32x2 pw; pw.x = pk_bf16(st[8][0], st[8][1]); pw.y = pk_bf16(st[8][2], st[8][3]);
            const bf16x4 pf = __builtin_bit_cast(bf16x4, pw);
#pragma unroll
            for (int dd = 0; dd < 4; ++dd) ot[dd] = mfma16(vl8[dd], pf, ot[dd]);
        }
        if (!FINAL) {
            const float inv = 1.0f / lsum;
            bf16_t* op = OP + (size_t)c.qtok * 512 + h * 64 + 4 * fq;
#pragma unroll
            for (int dd = 0; dd < 4; ++dd) { u32x2 o; o.x = pk_bf16(ot[dd][0] * inv, ot[dd][1] * inv); o.y = pk_bf16(ot[dd][2] * inv, ot[dd][3] * inv); *(u32x2*)(op + 16 * dd) = o; }
            if (fq == 0) ML[(size_t)c.qtok * 8 + h] = (f32x2){mx, lsum};
        } else {
            const float M = fmaxf(mx, fmaxf(a2.x, a3.x));
            const float w1 = __builtin_amdgcn_exp2f(mx - M), w2 = a2.y * __builtin_amdgcn_exp2f(a2.x - M), w3 = a3.y * __builtin_amdgcn_exp2f(a3.x - M);
            const float inv = 1.0f / (lsum * w1 + w2 + w3);
            const float c1 = w1 * inv, c2 = w2 * inv, c3 = w3 * inv;
            bf16_t* yp = Y + (size_t)c.qtok * DM + 256 + h * 64 + 4 * fq;
#pragma unroll
            for (int dd = 0; dd < 4; ++dd) {
                const float y0 = ot[dd][0] * c1 + bf_lo(o2[dd].x) * c2 + bf_lo(o3[dd].x) * c3, y1 = ot[dd][1] * c1 + bf_hi(o2[dd].x) * c2 + bf_hi(o3[dd].x) * c3;
                const float y2 = ot[dd][2] * c1 + bf_lo(o2[dd].y) * c2 + bf_lo(o3[dd].y) * c3, y3 = ot[dd][3] * c1 + bf_hi(o2[dd].y) * c2 + bf_hi(o3[dd].y) * c3;
                u32x2 o; o.x = pk_bf16(y0, y1); o.y = pk_bf16(y2, y3); *(u32x2*)(yp + 16 * dd) = o; }
        }
        __syncthreads();
    }
}

template <bool FINAL>
__device__ __forceinline__ void attn_step(LAS unsigned char* lds, const bf16_t* Z, int d, bf16_t* OP, f32x2* ML, const bf16_t* OP2, const bf16_t* OP3, const f32x2* ML2, const f32x2* ML3, bf16_t* Y,
                                          int au, int G, int tid, u32x4 (&kr)[4], u32x4 (&vr)[4], bf16x8 (&qn)[2], AttnCur& cn, int& hn) {
    const int lane = tid & 63, w = tid >> 6, fr = lane & 15, fq = lane >> 4;
    constexpr int NU = 6144;
#pragma unroll
    for (int it = 0; it < 4; ++it) { const int idx = tid + NTHR * it, row = idx >> 3, ch = idx & 7;
        *(LAS u32x4*)(lds + row * KSTR + ch * 16) = kr[it]; *(LAS u32x4*)(lds + ATT_V_OFF + row * VSTR + ch * 16) = vr[it]; }
    const AttnCur c = cn; const int h = hn; bf16x8 qf[2] = {qn[0], qn[1]};
    __syncthreads();
    u32x2 o2[4], o3[4]; f32x2 a2, a3;
    if (FINAL) {
        const bf16_t* p2 = OP2 + (size_t)c.qtok * 512 + h * 64 + 4 * fq; const bf16_t* p3 = OP3 + (size_t)c.qtok * 512 + h * 64 + 4 * fq;
#pragma unroll
        for (int dd = 0; dd < 4; ++dd) { o2[dd] = *(const u32x2*)(p2 + 16 * dd); o3[dd] = *(const u32x2*)(p3 + 16 * dd); }
    }
    attn_load(Z, (au + 2 * G < NU) ? au + 2 * G : au, d, tid, kr, vr, qn, cn, hn);
    f32x4 st[9];
    {
        bf16x8 kf[9];
#pragma unroll
        for (int t = 0; t < 9; ++t) kf[t] = *(const LAS bf16x8*)(lds + (16 * w + 16 * t + fr) * KSTR + (8 * fq) * 2);
        asm volatile("s_waitcnt lgkmcnt(0)" ::: "memory");
        __builtin_amdgcn_sched_barrier(0);
#pragma unroll
        for (int t = 0; t < 9; ++t) { st[t] = mfma32(kf[t], qf[0], (f32x4){0.f, 0.f, 0.f, 0.f}); }
        __builtin_amdgcn_sched_barrier(0);
#pragma unroll
        for (int t = 0; t < 9; ++t) kf[t] = *(const LAS bf16x8*)(lds + (16 * w + 16 * t + fr) * KSTR + (8 * fq + 32) * 2);
        asm volatile("s_waitcnt lgkmcnt(0)" ::: "memory");
        __builtin_amdgcn_sched_barrier(0);
#pragma unroll
        for (int t = 0; t < 9; ++t) { st[t] = mfma32(kf[t], qf[1], st[t]); }
    }
    const int tg = lane >> 4, tq = (lane >> 2) & 3, tp = lane & 3;
    const LAS unsigned char* vb = lds + ATT_V_OFF + (16 * w + 4 * tg + tq) * VSTR + tp * 8;
    bf16x4 vlo[2][4], vhi[2][4];
#pragma unroll
    for (int ks = 0; ks < 2; ++ks)
#pragma unroll
        for (int dd = 0; dd < 4; ++dd) { vlo[ks][dd] = tr4(vb + (32 * ks) * VSTR + dd * 32); vhi[ks][dd] = tr4(vb + (32 * ks + 16) * VSTR + dd * 32); }
    __builtin_amdgcn_sched_barrier(0);
    float mx = -1e30f;
    const int fkb = c.f0 + 16 * w - 64;
#pragma unroll
    for (int j = 0; j < 4; ++j) { if (4 * fq + j < fr) st[0][j] = -1e30f; if (4 * fq + j > fr) st[8][j] = -1e30f; }
    if ((fkb < 0) || (fkb + 144 > c.Ld)) {
#pragma unroll
        for (int t = 0; t < 9; ++t)
#pragma unroll
            for (int j = 0; j < 4; ++j) { const int fk = fkb + 16 * t + 4 * fq + j; if (fk < 0 || fk >= c.Ld) st[t][j] = -1e30f; }
    }
#pragma unroll
    for (int t = 0; t < 9; ++t) mx = fmaxf(mx, fmaxf(fmaxf(st[t][0], st[t][1]), fmaxf(st[t][2], st[t][3])));
    mx = fmaxf(mx, __shfl_xor(mx, 16)); mx = fmaxf(mx, __shfl_xor(mx, 32));
    float lsum = 0.f;
#pragma unroll
    for (int t = 0; t < 9; ++t)
#pragma unroll
        for (int j = 0; j < 4; ++j) { const float p = __builtin_amdgcn_exp2f(st[t][j] - mx); st[t][j] = p; lsum += p; }
    lsum += __shfl_xor(lsum, 16); lsum += __shfl_xor(lsum, 32);
    f32x4 ot[4];
#pragma unroll
    for (int dd = 0; dd < 4; ++dd) ot[dd] = (f32x4){0.f, 0.f, 0.f, 0.f};
    asm volatile("s_waitcnt lgkmcnt(0)" ::: "memory");
    __builtin_amdgcn_sched_barrier(0);
#pragma unroll
    for (int ks = 0; ks < 2; ++ks) {
        u32x4 pw; pw.x = pk_bf16(st[2 * ks][0], st[2 * ks][1]); pw.y = pk_bf16(st[2 * ks][2], st[2 * ks][3]); pw.z = pk_bf16(st[2 * ks + 1][0], st[2 * ks + 1][1]); pw.w = pk_bf16(st[2 * ks + 1][2], st[2 * ks + 1][3]);
        const bf16x8 pf = __builtin_bit_cast(bf16x8, pw);
#pragma unroll
        for (int dd = 0; dd < 4; ++dd) { const bf16x4 lo = vlo[ks][dd], hi = vhi[ks][dd];
            const bf16x8 vf = {lo[0], lo[1], lo[2], lo[3], hi[0], hi[1], hi[2], hi[3]}; ot[dd] = mfma32(vf, pf, ot[dd]); }
    }
    __builtin_amdgcn_sched_barrier(0);
    {
        bf16x4 wlo[4], whi[4], vl8[4];
#pragma unroll
        for (int dd = 0; dd < 4; ++dd) { wlo[dd] = tr4(vb + (32 * 2) * VSTR + dd * 32); whi[dd] = tr4(vb + (32 * 2 + 16) * VSTR + dd * 32); }
#pragma unroll
        for (int dd = 0; dd < 4; ++dd) vl8[dd] = tr4(vb + 128 * VSTR + dd * 32);
        asm volatile("s_waitcnt lgkmcnt(0)" ::: "memory");
        __builtin_amdgcn_sched_barrier(0);
        {
            u32x4 pw; pw.x = pk_bf16(st[4][0], st[4][1]); pw.y = pk_bf16(st[4][2], st[4][3]); pw.z = pk_bf16(st[5][0], st[5][1]); pw.w = pk_bf16(st[5][2], st[5][3]);
            const bf16x8 pf = __builtin_bit_cast(bf16x8, pw);
#pragma unroll
            for (int dd = 0; dd < 4; ++dd) { const bf16x4 lo = wlo[dd], hi = whi[dd];
                const bf16x8 vf = {lo[0], lo[1], lo[2], lo[3], hi[0], hi[1], hi[2], hi[3]}; ot[dd] = mfma32(vf, pf, ot[dd]); }
            u32x2 pw2; pw2.x = pk_bf16(st[8][0], st[8][1]); pw2.y = pk_bf16(st[8][2], st[8][3]);
            const bf16x4 pf4 = __builtin_bit_cast(bf16x4, pw2);
#pragma unroll
            for (int dd = 0; dd < 4; ++dd) ot[dd] = mfma16(vl8[dd], pf4, ot[dd]);
        }
        __builtin_amdgcn_sched_barrier(0);
#pragma unroll
        for (int dd = 0; dd < 4; ++dd) { wlo[dd] = tr4(vb + (32 * 3) * VSTR + dd * 32); whi[dd] = tr4(vb + (32 * 3 + 16) * VSTR + dd * 32); }
        asm volatile("s_waitcnt lgkmcnt(0)" ::: "memory");
        __builtin_amdgcn_sched_barrier(0);
        {
            u32x4 pw; pw.x = pk_bf16(st[6][0], st[6][1]); pw.y = pk_bf16(st[6][2], st[6][3]); pw.z = pk_bf16(st[7][0], st[7][1]); pw.w = pk_bf16(st[7][2], st[7][3]);
            const bf16x8 pf = __builtin_bit_cast(bf16x8, pw);
#pragma unroll
            for (int dd = 0; dd < 4; ++dd) { const bf16x4 lo = wlo[dd], hi = whi[dd];
                const bf16x8 vf = {lo[0], lo[1], lo[2], lo[3], hi[0], hi[1], hi[2], hi[3]}; ot[dd] = mfma32(vf, pf, ot[dd]); }
        }
    }
    if (!FINAL) {
        const float inv = 1.0f / lsum;
        bf16_t* op = OP + (size_t)c.qtok * 512 + h * 64 + 4 * fq;
#pragma unroll
        for (int dd = 0; dd < 4; ++dd) { u32x2 o; o.x = pk_bf16(ot[dd][0] * inv, ot[dd][1] * inv); o.y = pk_bf16(ot[dd][2] * inv, ot[dd][3] * inv); *(u32x2*)(op + 16 * dd) = o; }
        if (fq == 0) ML[(size_t)c.qtok * 8 + h] = (f32x2){mx, lsum};
    } else {
        a2 = ML2[(size_t)c.qtok * 8 + h]; a3 = ML3[(size_t)c.qtok * 8 + h];
        const float M = fmaxf(mx, fmaxf(a2.x, a3.x));
        const float w1 = __builtin_amdgcn_exp2f(mx - M), w2 = a2.y * __builtin_amdgcn_exp2f(a2.x - M), w3 = a3.y * __builtin_amdgcn_exp2f(a3.x - M);
        const float inv = 1.0f / (lsum * w1 + w2 + w3);
        const float c1 = w1 * inv, c2 = w2 * inv, c3 = w3 * inv;
        bf16_t* yp = Y + (size_t)c.qtok * DM + 256 + h * 64 + 4 * fq;
#pragma unroll
        for (int dd = 0; dd < 4; ++dd) {
            const float y0 = ot[dd][0] * c1 + bf_lo(o2[dd].x) * c2 + bf_lo(o3[dd].x) * c3, y1 = ot[dd][1] * c1 + bf_hi(o2[dd].x) * c2 + bf_hi(o3[dd].x) * c3;
            const float y2 = ot[dd][2] * c1 + bf_lo(o2[dd].y) * c2 + bf_lo(o3[dd].y) * c3, y3 = ot[dd][3] * c1 + bf_hi(o2[dd].y) * c2 + bf_hi(o3[dd].y) * c3;
            u32x2 o; o.x = pk_bf16(y0, y1); o.y = pk_bf16(y2, y3); *(u32x2*)(yp + 16 * dd) = o; }
    }
    __syncthreads();
}
template <bool FINAL>
__device__ __forceinline__ void attn_phase(LAS unsigned char* lds, const bf16_t* Z, int d, bf16_t* OP, f32x2* ML, const bf16_t* OP2, const bf16_t* OP3, const f32x2* ML2, const f32x2* ML3, bf16_t* Y) {
    const int tid = opaque_tid(), G = gridDim.x;
    constexpr int NU = 6144;
    int au = blockIdx.x;
    if (au >= NU) return;
    u32x4 krA[4], vrA[4], krB[4], vrB[4]; bf16x8 qA[2], qB[2]; AttnCur cA, cB; int hA, hB;
    attn_load(Z, au, d, tid, krA, vrA, qA, cA, hA);
    attn_load(Z, (au + G < NU) ? au + G : au, d, tid, krB, vrB, qB, cB, hB);
    for (;;) {
        attn_step<FINAL>(lds, Z, d, OP, ML, OP2, OP3, ML2, ML3, Y, au, G, tid, krA, vrA, qA, cA, hA);
        au += G; if (au >= NU) break;
        attn_step<FINAL>(lds, Z, d, OP, ML, OP2, OP3, ML2, ML3, Y, au, G, tid, krB, vrB, qB, cB, hB);
        au += G; if (au >= NU) break;
    }
}
constexpr int A2_ROWS = 384, A2_V_OFF = A2_ROWS * KSTR;
struct Attn2Cur { int qtok0, f0, Ld, dstep, p16; };
template <bool FINAL>
__device__ __forceinline__ void attn2_load(const bf16_t* Z, int au, int d, int tid, u32x4 (&kr)[6], u32x4 (&vr)[6], Attn2Cur& c, int& hh) {
    const int lane = tid & 63, w = tid >> 6, fr = lane & 15, fq = lane >> 4;
    const int h = au & 7, v = au >> 3, reg = FINAL ? 0 : (v >> 5), r = FINAL ? 0 : (v & 31);
    int b, rb, S; row_info(FINAL ? v * 256 : reg * 4096, b, rb, S);
    const int rpos = (FINAL ? v * 256 : reg * 4096) - rb;
    const int ld = FINAL ? 0 : ((r < 16) ? 4 : 2); d = 1 << ld;
    const int rho = FINAL ? 0 : ((r < 16) ? r : ((r - 16) >> 2));
    const int f0 = (rpos >> ld) + ((FINAL || r < 16) ? 0 : ((r - 16) & 3) * 256), Ld = S >> ld;
#pragma unroll
    for (int it = 0; it < 6; ++it) {
        const int idx = tid + NTHR * it, row = idx >> 3, ch = idx & 7, fk = f0 - 64 + row;
        u32x4 kv = {0u, 0u, 0u, 0u}, vv = {0u, 0u, 0u, 0u};
        if (fk >= 0 && fk < Ld) { const bf16_t* zr = Z + (size_t)(rb + fk * d + rho) * PROJ + h * 64 + ch * 8; kv = *(const u32x4*)(zr + 768); vv = *(const u32x4*)(zr + 1280); }
        kr[it] = kv; vr[it] = vv;
    }
    c.qtok0 = rb + (f0 + 32 * w + fr) * d + rho; c.dstep = 16 * d; c.f0 = f0; c.Ld = Ld; c.p16 = (r < 16) ? 1 : 0; hh = h;
}
__device__ __forceinline__ void attn2_loadq(const bf16_t* Z, const Attn2Cur& c, int h, int fq, bf16x8 (&qf)[2][2]) {
#pragma unroll
    for (int qi = 0; qi < 2; ++qi)
#pragma unroll
        for (int kk = 0; kk < 2; ++kk) qf[qi][kk] = *(const bf16x8*)(Z + (size_t)(c.qtok0 + qi * c.dstep) * PROJ + 256 + h * 64 + 8 * fq + 32 * kk);
}
template <bool FINAL>
__device__ __forceinline__ void attn2_phase(LAS unsigned char* lds, const bf16_t* Z, bf16_t* OP16, f32x2* ML16, bf16_t* OP4, f32x2* ML4, bf16_t* Y) {
    const int d = 0;
    const int tid = opaque_tid(), lane = tid & 63, w = tid >> 6, fr = lane & 15, fq = lane >> 4, G = gridDim.x;
    constexpr int NU = FINAL ? 3072 : 24 * 32 * 8;
    u32x4 kr[6], vr[6]; bf16x8 qf[2][2]; Attn2Cur cn; int hn;
    int au = blockIdx.x;
    if (au >= NU) return;
    attn2_load<FINAL>(Z, au, d, tid, kr, vr, cn, hn);
    attn2_loadq(Z, cn, hn, fq, qf);
    for (; au < NU; au += G) {
#pragma unroll
        for (int it = 0; it < 6; ++it) { const int idx = tid + NTHR * it, row = idx >> 3, ch = idx & 7;
            *(LAS u32x4*)(lds + row * KSTR + ch * 16) = kr[it]; *(LAS u32x4*)(lds + A2_V_OFF + row * VSTR + ch * 16) = vr[it]; }
        const Attn2Cur c = cn; const int h = hn;
        __syncthreads();
        { const int an = (au + G < NU) ? au + G : au; attn2_load<FINAL>(Z, an, d, tid, kr, vr, cn, hn); }
        f32x4 st[2][9];
#pragma unroll
        for (int qi = 0; qi < 2; ++qi)
#pragma unroll
            for (int tt = 0; tt < 9; ++tt) st[qi][tt] = (f32x4){0.f, 0.f, 0.f, 0.f};
#pragma unroll
        for (int kk = 0; kk < 2; ++kk) {
#pragma unroll
            for (int kh = 0; kh < 2; ++kh) {
                bf16x8 kf[5];
#pragma unroll
                for (int i = 0; i < 5; ++i) kf[i] = *(const LAS bf16x8*)(lds + (32 * w + 16 * (5 * kh + i) + fr) * KSTR + (8 * fq + 32 * kk) * 2);
                asm volatile("s_waitcnt lgkmcnt(0)" ::: "memory");
                __builtin_amdgcn_sched_barrier(0);
#pragma unroll
                for (int i = 0; i < 5; ++i) { const int kt = 5 * kh + i;
                    if (kt < 9) st[0][kt] = mfma32(kf[i], qf[0][kk], st[0][kt]);
                    if (kt > 0) st[1][kt - 1] = mfma32(kf[i], qf[1][kk], st[1][kt - 1]);
                }
                __builtin_amdgcn_sched_barrier(0);
            }
        }
        attn2_loadq(Z, cn, hn, fq, qf);
        float mx[2], lsum[2];
        const int fkb = c.f0 + 32 * w - 64;
        const bool edge = (fkb < 0) || (fkb + 160 > c.Ld);
#pragma unroll
        for (int qi = 0; qi < 2; ++qi) {
            float m = -1e30f;
#pragma unroll
            for (int j = 0; j < 4; ++j) { if (4 * fq + j < fr) st[qi][0][j] = -1e30f; if (4 * fq + j > fr) st[qi][8][j] = -1e30f; }
            if (edge) {
#pragma unroll
                for (int tt = 0; tt < 9; ++tt)
#pragma unroll
                    for (int j = 0; j < 4; ++j) { const int fk = fkb + 16 * (qi + tt) + 4 * fq + j; if (fk < 0 || fk >= c.Ld) st[qi][tt][j] = -1e30f; }
            }
#pragma unroll
            for (int tt = 0; tt < 9; ++tt) m = fmaxf(m, fmaxf(fmaxf(st[qi][tt][0], st[qi][tt][1]), fmaxf(st[qi][tt][2], st[qi][tt][3])));
            m = fmaxf(m, __shfl_xor(m, 16)); m = fmaxf(m, __shfl_xor(m, 32));
            float l = 0.f;
#pragma unroll
            for (int tt = 0; tt < 9; ++tt)
#pragma unroll
                for (int j = 0; j < 4; ++j) { const float p = __builtin_amdgcn_exp2f(st[qi][tt][j] - m); st[qi][tt][j] = p; l += p; }
            l += __shfl_xor(l, 16); l += __shfl_xor(l, 32);
            mx[qi] = m; lsum[qi] = l;
            __builtin_amdgcn_sched_barrier(0);
        }
        u32x2 pp[2][9];
#pragma unroll
        for (int qi = 0; qi < 2; ++qi)
#pragma unroll
            for (int tt = 0; tt < 9; ++tt) { pp[qi][tt].x = pk_bf16(st[qi][tt][0], st[qi][tt][1]); pp[qi][tt].y = pk_bf16(st[qi][tt][2], st[qi][tt][3]); }
        __builtin_amdgcn_sched_barrier(0);
        u32x2 o16[2][4], o4[2][4]; f32x2 a16[2], a4[2];
        if (FINAL) {
#pragma unroll
            for (int qi = 0; qi < 2; ++qi) { const int qtok = c.qtok0 + qi * c.dstep;
                a16[qi] = ML16[(size_t)qtok * 8 + h]; a4[qi] = ML4[(size_t)qtok * 8 + h];
                const bf16_t* p16 = OP16 + (size_t)qtok * 512 + h * 64 + 4 * fq; const bf16_t* p4 = OP4 + (size_t)qtok * 512 + h * 64 + 4 * fq;
#pragma unroll
                for (int dd = 0; dd < 4; ++dd) { o16[qi][dd] = *(const u32x2*)(p16 + 16 * dd); o4[qi][dd] = *(const u32x2*)(p4 + 16 * dd); } }
            __builtin_amdgcn_sched_barrier(0);
        }
        f32x4 ot[2][4];
#pragma unroll
        for (int qi = 0; qi < 2; ++qi)
#pragma unroll
            for (int dd = 0; dd < 4; ++dd) ot[qi][dd] = (f32x4){0.f, 0.f, 0.f, 0.f};
        const int tg = lane >> 4, tq = (lane >> 2) & 3, tp = lane & 3;
        const LAS unsigned char* vb = lds + A2_V_OFF + (32 * w + 4 * tg + tq) * VSTR + tp * 8;
#pragma unroll
        for (int ks = 0; ks < 5; ++ks) {
            bf16x4 vlo[4], vhi[4];
#pragma unroll
            for (int dd = 0; dd < 4; ++dd) { vlo[dd] = tr4(vb + (32 * ks) * VSTR + dd * 32); vhi[dd] = tr4(vb + (32 * ks + 16) * VSTR + dd * 32); }
            u32x4 pw0, pw1;
            pw0.x = pp[0][2 * ks].x; pw0.y = pp[0][2 * ks].y;
            if (ks < 4) { pw0.z = pp[0][2 * ks + 1].x; pw0.w = pp[0][2 * ks + 1].y; } else { pw0.z = 0u; pw0.w = 0u; }
            if (ks > 0) { pw1.x = pp[1][2 * ks - 1].x; pw1.y = pp[1][2 * ks - 1].y; } else { pw1.x = 0u; pw1.y = 0u; }
            pw1.z = pp[1][2 * ks].x; pw1.w = pp[1][2 * ks].y;
            const bf16x8 pf0 = __builtin_bit_cast(bf16x8, pw0), pf1 = __builtin_bit_cast(bf16x8, pw1);
            asm volatile("s_waitcnt lgkmcnt(0)" ::: "memory");
            __builtin_amdgcn_sched_barrier(0);
#pragma unroll
            for (int dd = 0; dd < 4; ++dd) { const bf16x4 lo = vlo[dd], hi = vhi[dd];
                const bf16x8 vf = {lo[0], lo[1], lo[2], lo[3], hi[0], hi[1], hi[2], hi[3]};
                ot[0][dd] = mfma32(vf, pf0, ot[0][dd]); ot[1][dd] = mfma32(vf, pf1, ot[1][dd]); }
            __builtin_amdgcn_sched_barrier(0);
        }
#pragma unroll
        for (int qi = 0; qi < 2; ++qi) {
            const int qtok = c.qtok0 + qi * c.dstep;
            if (!FINAL) {
                const float inv = 1.0f / lsum[qi];
                bf16_t* op = (c.p16 ? OP16 : OP4) + (size_t)qtok * 512 + h * 64 + 4 * fq;
#pragma unroll
                for (int dd = 0; dd < 4; ++dd) { u32x2 o; o.x = pk_bf16(ot[qi][dd][0] * inv, ot[qi][dd][1] * inv); o.y = pk_bf16(ot[qi][dd][2] * inv, ot[qi][dd][3] * inv); *(u32x2*)(op + 16 * dd) = o; }
                if (fq == 0) (c.p16 ? ML16 : ML4)[(size_t)qtok * 8 + h] = (f32x2){mx[qi], lsum[qi]};
            } else {
                const f32x2 a2 = a4[qi], a3 = a16[qi];
                const float M = fmaxf(mx[qi], fmaxf(a2.x, a3.x));
                const float w1 = __builtin_amdgcn_exp2f(mx[qi] - M), w2 = a2.y * __builtin_amdgcn_exp2f(a2.x - M), w3 = a3.y * __builtin_amdgcn_exp2f(a3.x - M);
                const float inv = 1.0f / (lsum[qi] * w1 + w2 + w3);
                const float c1 = w1 * inv, c2 = w2 * inv, c3 = w3 * inv;
                bf16_t* yp = Y + (size_t)qtok * DM + 256 + h * 64 + 4 * fq;
#pragma unroll
                for (int dd = 0; dd < 4; ++dd) { const u32x2 p2 = o4[qi][dd], p3 = o16[qi][dd];
                    const float y0 = ot[qi][dd][0] * c1 + bf_lo(p2.x) * c2 + bf_lo(p3.x) * c3, y1 = ot[qi][dd][1] * c1 + bf_hi(p2.x) * c2 + bf_hi(p3.x) * c3;
                    const float y2 = ot[qi][dd][2] * c1 + bf_lo(p2.y) * c2 + bf_lo(p3.y) * c3, y3 = ot[qi][dd][3] * c1 + bf_hi(p2.y) * c2 + bf_hi(p3.y) * c3;
                    u32x2 o; o.x = pk_bf16(y0, y1); o.y = pk_bf16(y2, y3); *(u32x2*)(yp + 16 * dd) = o; }
            }
        }
        __syncthreads();
    }
}

constexpr int PSTR = 528;
__device__ __forceinline__ void pool_load(const bf16_t* Z, int tile, int tid, u32x4 (&pr)[9]) {
    int b, rb, S; row_info(tile * 128, b, rb, S);
    const int p0 = tile * 128 - rb - 8;
#pragma unroll
    for (int it = 0; it < 9; ++it) { const int idx = tid + NTHR * it, row = idx >> 5, ch = idx & 31, j = p0 + row;
        u32x4 v = {0u, 0u, 0u, 0u};
        if (j >= 0 && j < S) v = *(const u32x4*)(Z + (size_t)(rb + j) * PROJ + ch * 8);
        pr[it] = v; }
}
template <int G_>
__device__ __forceinline__ void pool_tiles(LAS unsigned char* lds, bf16_t* Y, const bf16x8 (&wf)[2][4], const f32x4 (&sc)[4], int S, int rb, int tile, int half, int fr, int fq) {
    constexpr int HW = 1 << G_;
#pragma unroll 1
    for (int mt = 0; mt < 4; ++mt) {
        const int tl = half * 64 + mt * 16 + fr, token = tile * 128 + tl, pos = token - rb;
        const int lo = (pos - HW > 0) ? pos - HW : 0, hi = (pos + HW < S) ? pos + HW : S;
        const float inv = 1.0f / (float)(hi - lo);
        f32x4 acc[4];
#pragma unroll
        for (int dd = 0; dd < 4; ++dd) acc[dd] = (f32x4){0.f, 0.f, 0.f, 0.f};
#pragma unroll
        for (int kk = 0; kk < 2; ++kk) {
            const LAS unsigned char* base = lds + (tl + 8 - HW) * PSTR + (G_ * 64 + 32 * kk + 8 * fq) * 2;
            float s[8];
#pragma unroll
            for (int i = 0; i < 8; ++i) s[i] = 0.f;
#pragma unroll
            for (int jj = 0; jj < 2 * HW; ++jj) {
                const u32x4 v = *(const LAS u32x4*)(base + jj * PSTR);
                s[0] += bf_lo(v.x); s[1] += bf_hi(v.x); s[2] += bf_lo(v.y); s[3] += bf_hi(v.y);
                s[4] += bf_lo(v.z); s[5] += bf_hi(v.z); s[6] += bf_lo(v.w); s[7] += bf_hi(v.w);
            }
            const u32x4 sv = *(const LAS u32x4*)(base + HW * PSTR);
            u32x4 pw;
            pw.x = pk_bf16(s[0] * inv - bf_lo(sv.x), s[1] * inv - bf_hi(sv.x)); pw.y = pk_bf16(s[2] * inv - bf_lo(sv.y), s[3] * inv - bf_hi(sv.y));
            pw.z = pk_bf16(s[4] * inv - bf_lo(sv.z), s[5] * inv - bf_hi(sv.z)); pw.w = pk_bf16(s[6] * inv - bf_lo(sv.w), s[7] * inv - bf_hi(sv.w));
            const bf16x8 pf = __builtin_bit_cast(bf16x8, pw);
#pragma unroll
            for (int dd = 0; dd < 4; ++dd) acc[dd] = mfma32(wf[kk][dd], pf, acc[dd]);
        }
#pragma unroll
        for (int dd = 0; dd < 4; ++dd) { const f32x4 o = acc[dd] * sc[dd];
            u32x2 ow; ow.x = pk_bf16(o.x, o.y); ow.y = pk_bf16(o.z, o.w); *(u32x2*)(Y + (size_t)token * DM + G_ * 64 + 16 * dd + 4 * fq) = ow; }
    }
}
__device__ __forceinline__ void pool_phase(LAS unsigned char* lds, const bf16_t* Z, bf16_t* Y, const bf16_t* pwt, const float* pscale) {
    const int tid = opaque_tid(), lane = tid & 63, w = __builtin_amdgcn_readfirstlane(tid >> 6), fr = lane & 15, fq = lane >> 4, G = gridDim.x;
    constexpr int NU = 768;
    int tile = blockIdx.x;
    if (tile >= NU) return;
    u32x4 pr[9];
    pool_load(Z, tile, tid, pr);
    const int g = w & 3, half = w >> 2;
    bf16x8 wf[2][4]; f32x4 sc[4];
#pragma unroll
    for (int kk = 0; kk < 2; ++kk)
#pragma unroll
        for (int dd = 0; dd < 4; ++dd) wf[kk][dd] = *(const bf16x8*)(pwt + (size_t)(g * 64 + 16 * dd + fr) * 64 + 32 * kk + 8 * fq);
#pragma unroll
    for (int dd = 0; dd < 4; ++dd) sc[dd] = *(const f32x4*)(pscale + g * 64 + 16 * dd + 4 * fq);
    for (; tile < NU; tile += G) {
#pragma unroll
        for (int it = 0; it < 9; ++it) { const int idx = tid + NTHR * it, row = idx >> 5, ch = idx & 31; *(LAS u32x4*)(lds + row * PSTR + ch * 16) = pr[it]; }
        __syncthreads();
        { const int tn = (tile + G < NU) ? tile + G : tile; pool_load(Z, tn, tid, pr); }
        int b, rb, S; row_info(tile * 128, b, rb, S);
        if (g == 0) pool_tiles<0>(lds, Y, wf, sc, S, rb, tile, half, fr, fq);
        else if (g == 1) pool_tiles<1>(lds, Y, wf, sc, S, rb, tile, half, fr, fq);
        else if (g == 2) pool_tiles<2>(lds, Y, wf, sc, S, rb, tile, half, fr, fq);
        else pool_tiles<3>(lds, Y, wf, sc, S, rb, tile, half, fr, fq);
        __syncthreads();
    }
}
__device__ __forceinline__ void sgu_load(const bf16_t* Z, int un, int tid, u32x4 (&vr)[2], u32x2 (&uv)[4]) {
    const int tile = un >> 2, g = un & 3, lane = tid & 63, w = tid >> 6, fr = lane & 15, fq = lane >> 4;
#pragma unroll
    for (int it = 0; it < 2; ++it) { const int idx = tid + NTHR * it, row = idx >> 3, ch = idx & 7; vr[it] = *(const u32x4*)(Z + (size_t)(tile * 128 + row) * PROJ + 2048 + g * 64 + ch * 8); }
#pragma unroll
    for (int cc = 0; cc < 4; ++cc) uv[cc] = *(const u32x2*)(Z + (size_t)(tile * 128 + 16 * w + fr) * PROJ + 1792 + g * 64 + 16 * cc + 4 * fq);
}
__device__ __forceinline__ void sgu_phase(LAS unsigned char* lds, const bf16_t* Z, bf16_t* Y, const bf16_t* sw, const float* sb) {
    const int tid = opaque_tid(), lane = tid & 63, w = tid >> 6, fr = lane & 15, fq = lane >> 4, G = gridDim.x;
    constexpr int NU = 3072;
    int un = blockIdx.x;
    if (un >= NU) return;
    u32x4 vr[2]; u32x2 un_uv[4];
    sgu_load(Z, un, tid, vr, un_uv);
    int gcur = -1; u32x2 wlo[4], whi[4]; float bias = 0.f;
    for (; un < NU; un += G) {
        const int tile = un >> 2, g = un & 3, t0 = tile * 128;
        if (g != gcur) { gcur = g;
            const bf16_t* wrow = sw + (size_t)(g * 128 + 16 * w + fr) * 128 + 4 * fq;
#pragma unroll
            for (int ks = 0; ks < 4; ++ks) { wlo[ks] = *(const u32x2*)(wrow + 32 * ks); whi[ks] = *(const u32x2*)(wrow + 32 * ks + 16); }
            bias = sb[g * 128 + 16 * w + fr]; }
#pragma unroll
        for (int it = 0; it < 2; ++it) {
            const int idx = tid + NTHR * it, row = idx >> 3, ch = idx & 7;
            const u32x4 v = vr[it];
            float x[8] = {bf_lo(v.x), bf_hi(v.x), bf_lo(v.y), bf_hi(v.y), bf_lo(v.z), bf_hi(v.z), bf_lo(v.w), bf_hi(v.w)};
            float s = ((x[0] + x[1]) + (x[2] + x[3])) + ((x[4] + x[5]) + (x[6] + x[7]));
            s += __shfl_xor(s, 1); s += __shfl_xor(s, 2); s += __shfl_xor(s, 4);
            const float mu = s * (1.0f / 64.0f);
            float q = 0.f;
#pragma unroll
            for (int i = 0; i < 8; ++i) { x[i] -= mu; q += x[i] * x[i]; }
            q += __shfl_xor(q, 1); q += __shfl_xor(q, 2); q += __shfl_xor(q, 4);
            const float rstd = 1.0f / sqrtf(q * (1.0f / 64.0f) + EPS);
            u32x4 o; o.x = pk_bf16(x[0] * rstd, x[1] * rstd); o.y = pk_bf16(x[2] * rstd, x[3] * rstd); o.z = pk_bf16(x[4] * rstd, x[5] * rstd); o.w = pk_bf16(x[6] * rstd, x[7] * rstd);
            *(LAS u32x4*)(lds + row * VSTR + ch * 16) = o;
        }
        __syncthreads();
        const int token = t0 + 16 * w + fr;
        u32x2 uv[4];
#pragma unroll
        for (int cc = 0; cc < 4; ++cc) uv[cc] = un_uv[cc];
        { const int nn = (un + G < NU) ? un + G : un; sgu_load(Z, nn, tid, vr, un_uv); }
        f32x4 acc[4];
#pragma unroll
        for (int cc = 0; cc < 4; ++cc) acc[cc] = (f32x4){0.f, 0.f, 0.f, 0.f};
        const int tg = lane >> 4, tq = (lane >> 2) & 3, tp = lane & 3;
        const LAS unsigned char* vb = lds + (4 * tg + tq) * VSTR + tp * 8;
#pragma unroll
        for (int ks = 0; ks < 4; ++ks) {
            const u32x4 ww = {wlo[ks].x, wlo[ks].y, whi[ks].x, whi[ks].y};
            const bf16x8 wf = __builtin_bit_cast(bf16x8, ww);
#pragma unroll
            for (int cc = 0; cc < 4; ++cc) { const bf16x4 lo = tr4(vb + (32 * ks) * VSTR + cc * 32), hi = tr4(vb + (32 * ks + 16) * VSTR + cc * 32);
                const bf16x8 vf = {lo[0], lo[1], lo[2], lo[3], hi[0], hi[1], hi[2], hi[3]}; acc[cc] = mfma32(vf, wf, acc[cc]); }
        }
#pragma unroll
        for (int cc = 0; cc < 4; ++cc) {
            u32x2 o; o.x = pk_bf16((acc[cc][0] + bias) * bf_lo(uv[cc].x), (acc[cc][1] + bias) * bf_hi(uv[cc].x)); o.y = pk_bf16((acc[cc][2] + bias) * bf_lo(uv[cc].y), (acc[cc][3] + bias) * bf_hi(uv[cc].y));
            *(u32x2*)(Y + (size_t)token * DM + 768 + g * 64 + 16 * cc + 4 * fq) = o; }
        __syncthreads();
    }
}

constexpr int N_PHASES = 15;
__global__ void __launch_bounds__(NTHR, 2) fwd_kernel(Args A) {
    extern __shared__ __attribute__((aligned(16))) unsigned char lds_raw[];
    LAS unsigned char* lds = (LAS unsigned char*)lds_raw;
    cg::grid_group grid = cg::this_grid();
    unsigned char* ws = A.ws;
    const int G = gridDim.x;
    bf16_t* H = (bf16_t*)(ws + WS_H); bf16_t* Zb = (bf16_t*)(ws + WS_Z); bf16_t* Yb = (bf16_t*)(ws + WS_Y); bf16_t* Ub = (bf16_t*)(ws + WS_U);
    bf16_t* OP2 = (bf16_t*)A.out; bf16_t* OP3 = (bf16_t*)A.out + (size_t)TT * 512;
    f32x2* ML2 = (f32x2*)(ws + WS_ML2); f32x2* ML3 = (f32x2*)(ws + WS_ML3);
    const float* mod = (const float*)(ws + WS_MOD);
    const int lo = A.ph_lo, hi = A.ph_hi;
#ifndef PHMASK
#define PHMASK 0x1FF
#endif
#define PM(i) (((PHMASK) >> (i)) & 1)
#ifndef REP_N1
#define REP_N1 1
#endif
#ifndef REP_G1
#define REP_G1 1
#endif
#ifndef REP_MA
#define REP_MA 1
#endif
#ifndef REP_MB
#define REP_MB 1
#endif
#ifndef REP_G3
#define REP_G3 1
#endif
#define IN(k) (lo <= (k) && (k) < hi)
#define SEAM(k) do { if (IN(k) && IN((k) + 1)) grid.sync(); } while (0)
    if (PM(0) && IN(0)) { p0_prologue(A, lds); }
    SEAM(0);
    float* rowsq = (float*)(ws + WS_ROWSQ); float* shw = (float*)(ws + WS_SHW);
    if (PM(1) && IN(1)) prep_phase(A.x_p, A.x_s, A.g_mix, mod, H, rowsq, mod, (const bf16_t*)(ws + WS_WIN), (const bf16_t*)(ws + WS_WUP), shw);
    SEAM(1);
    for (int l = 0; l < 2; ++l) {
        const int pb = 2 + 6 * l;
        const float* modl = mod + (size_t)l * NB * 6144;
        const float* shwl = shw + (size_t)l * (NB * 6400);
        if (PM(2) && IN(pb + 0)) for (int rep = 0; rep < REP_G1; ++rep) {
            pg8::Gemm g{H, (const bf16_t*)(ws + WS_WIN) + (size_t)l * PROJ * DM, TT, PROJ, DM}; pg8::StaticOrder S; S.init(TT, PROJ, G, (int)blockIdx.x);
            pg8::EpiZ E{Zb, (const float*)(ws + WS_ROPE), rowsq + (size_t)(2 * l) * TT, shwl};
            pg8::gemm_phase<pg8::EpiZ, pg8::StaticOrder, true, true>(lds, g, S, E);
        }
        SEAM(pb + 0);
        if (PM(3) && IN(pb + 1)) for (int rep = 0; rep < REP_MA; ++rep) {
            const bf16_t* pwt = (const bf16_t*)(ws + WS_PWT) + (size_t)l * 4 * 4096; const bf16_t* sw = (const bf16_t*)(ws + WS_SGUW) + (size_t)l * 4 * 16384;
            attn2_phase<false>(lds, Zb, OP3, ML3, OP2, ML2, nullptr);
            sgu_phase(lds, Zb, Yb, sw, A.sgu_b + l * 512);
            pool_phase(lds, Zb, Yb, pwt, A.pool_scale + l * 256);
        }
        SEAM(pb + 1);
        if (PM(4) && IN(pb + 2)) for (int rep = 0; rep < REP_MB; ++rep) {
            attn2_phase<true>(lds, Zb, OP3, ML3, OP2, ML2, Yb);
        }
        SEAM(pb + 2);
        if (PM(5) && IN(pb + 3)) {
            pg8::Gemm g{Yb, (const bf16_t*)(ws + WS_WOUT) + (size_t)l * DM * DM, TT, DM, DM}; pg8::StaticOrder S; S.init(TT, DM, G, (int)blockIdx.x);
            pg8::EpiRes E{A.x_p, A.x_s, H, A.g_mix + l * DM, modl + 1024, modl + 2048, H, A.g_mlp + l * DM, modl + 4096, rowsq + (size_t)(2 * l + 1) * TT};
            pg8::gemm_phase<pg8::EpiRes, pg8::StaticOrder, true, true>(lds, g, S, E);
        }
        SEAM(pb + 3);
        if (PM(6) && IN(pb + 4)) for (int rep = 0; rep < REP_G3; ++rep) {
            pg8::Gemm g{H, (const bf16_t*)(ws + WS_WUP) + (size_t)l * DFF * DM, TT, DFF, DM}; pg8::StaticOrder S; S.init(TT, DFF, G, (int)blockIdx.x);
            pg8::EpiRelu2 E{Ub, DFF, rowsq + (size_t)(2 * l + 1) * TT, shwl + NB * 2304};
            pg8::gemm_phase<pg8::EpiRelu2, pg8::StaticOrder, true, true>(lds, g, S, E);
        }
        SEAM(pb + 4);
        if (PM(7) && IN(pb + 5)) {
            pg8::Gemm g{Ub, (const bf16_t*)(ws + WS_WDOWN) + (size_t)l * DM * DFF, TT, DM, DFF}; pg8::StaticOrder S; S.init(TT, DM, G, (int)blockIdx.x, 1);
            pg8::EpiRes E{A.x_p, A.x_s, H, A.g_mlp + l * DM, modl + 4096, modl + 5120, H, (l == 0) ? A.g_mix + DM : A.g_final, (l == 0) ? mod + (size_t)NB * 6144 + 1024 : (const float*)nullptr, rowsq + (size_t)(2 * l + 2) * TT};
            pg8::gemm_phase<pg8::EpiRes, pg8::StaticOrder, true, true>(lds, g, S, E);
        }
        SEAM(pb + 5);
    }
    if (PM(8) && IN(14)) final_norm_phase(A.out, H, rowsq + (size_t)4 * TT);
#undef IN
#undef SEAM
}

#ifndef MK_SPLIT
#define MK_SPLIT 0
#endif
extern "C" void kernel_launch(void* const* d_in, const int* in_sizes, int n_in, void* d_out, int out_size, void* d_ws, size_t ws_size, hipStream_t stream) {
    static int grid = 0;
    if (grid == 0) {
        if (n_in != 17 || out_size != TT * DM || ws_size < WS_END) { fprintf(stderr, "kernel_launch: unexpected shapes: n_in %d out %d ws %zu\n", n_in, out_size, ws_size); grid = -1; return; }
        int dev = 0, cus = 0, per_cu = 0;
        hipGetDevice(&dev); hipDeviceGetAttribute(&cus, hipDeviceAttributeMultiprocessorCount, dev);
        if (hipFuncSetAttribute((const void*)fwd_kernel, hipFuncAttributeMaxDynamicSharedMemorySize, LDS_BYTES) != hipSuccess) { fprintf(stderr, "kernel_launch: hipFuncSetAttribute failed\n"); grid = -1; return; }
        if (hipOccupancyMaxActiveBlocksPerMultiprocessor(&per_cu, (const void*)fwd_kernel, NTHR, LDS_BYTES) != hipSuccess || per_cu < 1) { fprintf(stderr, "kernel_launch: occupancy query gave %d\n", per_cu); per_cu = 1; }
        (void)hipGetLastError();
        grid = cus * per_cu;
    }
    if (grid < 0) return;
    Args a{};
    a.x_p = (const float*)d_in[0]; a.x_s = (const float*)d_in[1]; a.c_p = (const float*)d_in[2]; a.c_s = (const float*)d_in[3]; a.w_ada = (const float*)d_in[4]; a.b_ada = (const float*)d_in[5];
    a.g_mix = (const float*)d_in[6]; a.g_mlp = (const float*)d_in[7]; a.w_in = (const float*)d_in[8]; a.pool_w = (const float*)d_in[9]; a.pool_scale = (const float*)d_in[10];
    a.sgu_w = (const float*)d_in[11]; a.sgu_b = (const float*)d_in[12]; a.w_out = (const float*)d_in[13]; a.w_up = (const float*)d_in[14]; a.w_down = (const float*)d_in[15]; a.g_final = (const float*)d_in[16];
    a.out = (float*)d_out; a.ws = (unsigned char*)d_ws;
#if MK_SPLIT
    for (int p = 0; p < N_PHASES; ++p) { a.ph_lo = p; a.ph_hi = p + 1; hipLaunchKernelGGL(fwd_kernel, dim3(grid), dim3(NTHR), LDS_BYTES, stream, a); }
#else
    a.ph_lo = 0; a.ph_hi = N_PHASES;
    void* args[] = {&a};
    hipError_t e = hipLaunchCooperativeKernel((const void*)fwd_kernel, dim3(grid), dim3(NTHR), args, LDS_BYTES, stream);
    if (e != hipSuccess) fprintf(stderr, "cooperative launch failed: %s (grid %d)\n", hipGetErrorString(e), grid);
#endif
}
```

```cpp
#include <hip/hip_runtime.h>
#include <hip/hip_cooperative_groups.h>
#include <cstdio>
#include <cstdint>
namespace cg = cooperative_groups;
__device__ __forceinline__ int opaque_tid() { int t = threadIdx.x; asm volatile("" : "+v"(t)); return t; }
namespace pg8 {
#define PG8_LAS __attribute__((address_space(3)))
typedef unsigned short bf16_t;
typedef short bf16x8 __attribute__((ext_vector_type(8)));
typedef float f32x4 __attribute__((ext_vector_type(4)));
typedef unsigned u32x4 __attribute__((ext_vector_type(4)));
constexpr int BM = 256, BK = 64, HALF = 128, HTB = HALF * BK * 2  , STAGE_BYTES = 8 * HTB, NXCD = 8, WGM = 8;

__host__ __device__ __forceinline__ int lds_byte(int r, int c) { const int st = (r >> 4) * 2 + (c >> 5), rr = r & 15, cc = c & 31, ob = rr * 64 + cc * 2; return st * 1024 + (ob ^ (((ob >> 9) & 1) << 5)); }
__host__ __device__ __forceinline__ void stage_rc(int b, int& R, int& C) { const int st = b / 1024, sb = b % 1024, swz = sb ^ (((sb >> 9) & 1) << 5); R = (st >> 1) * 16 + swz / 64; C = (st & 1) * 32 + (swz % 64) / 2; }
__host__ __device__ __forceinline__ int perm32(int rho) { const int n = rho >> 4, i = rho & 15; return 8 * (i >> 2) + 4 * n + (i & 3); }

struct Unit { int pm, pn; };
struct Gemm { const bf16_t* A; const bf16_t* Bt; int M, N, K; };

struct StaticOrder {
    int nM, nN, nwg, G, c, rev;
    __host__ __device__ void init(int M, int N, int G_, int c_, int rev_ = 0) { nM = M / BM; nN = N / BM; nwg = nM * nN; G = G_; c = c_; rev = rev_; }
    __host__ __device__ bool next(int i, Unit& u) const {
        const long L = (long)i * G + c; if (L >= nwg) return false;
        int wgid = (int)L; { const int q = nwg / NXCD, r = nwg % NXCD, xcd = wgid % NXCD; int off = wgid / NXCD; if (rev && r == 0) off = q - 1 - off; wgid = (xcd < r ? xcd * (q + 1) : r * (q + 1) + (xcd - r) * q) + off; }
        const int nig = WGM * nN, gid = wgid / nig, fm = gid * WGM, gsz = (nM - fm) < WGM ? (nM - fm) : WGM;
        u.pm = fm + ((wgid % nig) % gsz); u.pn = (wgid % nig) / gsz; return true;
    }
    __device__ __forceinline__ void a_ready(const Unit&) const {}
    __device__ __forceinline__ void done(const Unit&) const {}
};


typedef float f32x2 __attribute__((ext_vector_type(2)));
__device__ __forceinline__ unsigned cvt_pk_bf16(float lo, float hi) { typedef __bf16 b2 __attribute__((ext_vector_type(2))); f32x2 v = {lo, hi}; b2 b = __builtin_convertvector(v, b2); return __builtin_bit_cast(unsigned, b); }
__device__ __forceinline__ void tile_info(int pm, int& b, int& pos0) {
    if (pm < 128) { b = pm >> 6; pos0 = (pm & 63) << 8; } else { const int q = pm - 128; b = 2 + (q >> 5); pos0 = (q & 31) << 8; }
}
__device__ __forceinline__ float gelu_tanh(float x) {
    const float y = x * (1.0f + 0.044715f * x * x) * (2.0f * 0.7978845608028654f);
    const float e = __builtin_amdgcn_exp2f(-y * 1.4426950408889634f);
    return x * __builtin_amdgcn_rcpf(1.0f + e);
}
struct EpiZ {
    static constexpr bool PERM = true, AFTER_DRAIN = false;
    bf16_t* Z; const float* rope;
    const float* rowsq; const float* shw;
    __device__ __forceinline__ void operator()(const f32x4 (&acc)[2][2][4][2], const Unit& u, int wr, int wc, int fr_, int fq) const {
        int fr = fr_; asm volatile("" : "+v"(fr));
        int b, pos0; tile_info(u.pm, b, pos0);
        const int pn = u.pn;
        const bool rot = (pn >= 1 && pn <= 4) && ((wc & 1) == 0);
        const bool gel = (pn >= 7);
        const float qs = (pn == 1 || pn == 2) ? 0.125f * 1.4426950408889634f : 1.0f;
        const int row0 = u.pm * BM + wr * 64 + fr;
        const int col0 = pn * BM + wc * 32 + 8 * fq;
        f32x4 sv[2][2];
#pragma unroll
        for (int bj = 0; bj < 2; ++bj)
#pragma unroll
            for (int n = 0; n < 2; ++n) sv[bj][n] = *(const f32x4*)(shw + (size_t)b * 2304 + col0 + bj * HALF + 4 * n);
#pragma unroll
        for (int ai = 0; ai < 2; ++ai)
#pragma unroll
            for (int m = 0; m < 4; ++m) {
                const int rl = ai * HALF + m * 16;
                bf16_t* rowp = Z + (size_t)(row0 + rl) * 2304 + col0;
                const float rr = 1.0f / sqrtf(rowsq[row0 + rl] * (1.0f / 1024.0f) + 1e-6f);
                f32x4 cs[4];
                if (rot) { const f32x4* rp = (const f32x4*)(rope + (size_t)(pos0 + wr * 64 + fr + rl) * 16);
#pragma unroll
                    for (int i = 0; i < 4; ++i) cs[i] = rp[i]; }
#pragma unroll
                for (int bj = 0; bj < 2; ++bj) {
                    f32x4 v0 = acc[ai][bj][m][0] * rr + sv[bj][0], v1 = acc[ai][bj][m][1] * rr + sv[bj][1];
                    if (rot) {
                        f32x4 p0, p1;
#pragma unroll
                        for (int j = 0; j < 4; ++j) { p0[j] = __shfl_xor(v0[j], 16); p1[j] = __shfl_xor(v1[j], 16); }
                        const float sg = (fq == 0) ? -1.0f : 1.0f;
                        if (fq < 2) {
                            f32x4 r0, r1;
                            r0[0] = v0[0] * cs[0][0] + sg * p0[0] * cs[0][1]; r0[1] = v0[1] * cs[0][2] + sg * p0[1] * cs[0][3];
                            r0[2] = v0[2] * cs[1][0] + sg * p0[2] * cs[1][1]; r0[3] = v0[3] * cs[1][2] + sg * p0[3] * cs[1][3];
                            r1[0] = v1[0] * cs[2][0] + sg * p1[0] * cs[2][1]; r1[1] = v1[1] * cs[2][2] + sg * p1[1] * cs[2][3];
                            r1[2] = v1[2] * cs[3][0] + sg * p1[2] * cs[3][1]; r1[3] = v1[3] * cs[3][2] + sg * p1[3] * cs[3][3];
                            v0 = r0; v1 = r1;
                        }
                    }
                    if (gel) {
#pragma unroll
                        for (int j = 0; j < 4; ++j) { v0[j] = gelu_tanh(v0[j]); v1[j] = gelu_tanh(v1[j]); }
                    }
                    v0 = v0 * qs; v1 = v1 * qs;
                    u32x4 w; w.x = cvt_pk_bf16(v0[0], v0[1]); w.y = cvt_pk_bf16(v0[2], v0[3]); w.z = cvt_pk_bf16(v1[0], v1[1]); w.w = cvt_pk_bf16(v1[2], v1[3]);
                    *(u32x4*)(rowp + bj * HALF) = w;
                }
            }
    }
};
struct EpiRelu2 {
    static constexpr bool PERM = true, AFTER_DRAIN = false;
    bf16_t* O; int ldc; const float* rowsq; const float* shw;
    __device__ __forceinline__ void operator()(const f32x4 (&acc)[2][2][4][2], const Unit& u, int wr, int wc, int fr_, int fq) const {
        int fr = fr_; asm volatile("" : "+v"(fr));
        int b, pos0; tile_info(u.pm, b, pos0);
        const int row0 = u.pm * BM + wr * 64 + fr; const int col0 = u.pn * BM + wc * 32 + 8 * fq;
        f32x4 sv[2][2];
#pragma unroll
        for (int bj = 0; bj < 2; ++bj)
#pragma unroll
            for (int n = 0; n < 2; ++n) sv[bj][n] = *(const f32x4*)(shw + (size_t)b * 4096 + col0 + bj * HALF + 4 * n);
#pragma unroll
        for (int ai = 0; ai < 2; ++ai)
#pragma unroll
            for (int m = 0; m < 4; ++m) { bf16_t* rowp = O + (size_t)(row0 + ai * HALF + m * 16) * ldc + col0;
                const float rr = 1.0f / sqrtf(rowsq[row0 + ai * HALF + m * 16] * (1.0f / 1024.0f) + 1e-6f);
#pragma unroll
                for (int bj = 0; bj < 2; ++bj) { f32x4 v0 = acc[ai][bj][m][0] * rr + sv[bj][0], v1 = acc[ai][bj][m][1] * rr + sv[bj][1];
#pragma unroll
                    for (int j = 0; j < 4; ++j) { const float a = fmaxf(v0[j], 0.f), c = fmaxf(v1[j], 0.f); v0[j] = a * a; v1[j] = c * c; }
                    u32x4 w; w.x = cvt_pk_bf16(v0[0], v0[1]); w.y = cvt_pk_bf16(v0[2], v0[3]); w.z = cvt_pk_bf16(v1[0], v1[1]); w.w = cvt_pk_bf16(v1[2], v1[3]);
                    *(u32x4*)(rowp + bj * HALF) = w; } }
    }
};
struct EpiRes {
    static constexpr bool PERM = true, AFTER_DRAIN = false;
    const float* xin_p; const float* xin_s;
    const bf16_t* Hin; const float* gin; const float* scin;
    const float* gate;
    bf16_t* Hn; const float* gn; const float* scn;
    float* rowsq;
    __device__ __forceinline__ void operator()(const f32x4 (&acc)[2][2][4][2], const Unit& u, int wr, int wc, int fr_, int fq) const {
        int fr = fr_; asm volatile("" : "+v"(fr));
        int b, pos0; tile_info(u.pm, b, pos0);
        const float* base = (u.pm < 128) ? xin_p + (size_t)(u.pm * BM) * 1024 : xin_s + (size_t)(u.pm * BM - 32768) * 1024;
        const size_t hrow = (size_t)(u.pm * BM) * 1024;
        const int col0 = u.pn * BM + wc * 32 + 8 * fq;
        float ss[8];
#pragma unroll
        for (int i = 0; i < 8; ++i) ss[i] = 0.f;
#pragma unroll
        for (int bj = 0; bj < 2; ++bj) {
            const int c = col0 + bj * HALF;
            f32x4 gv[2], gs[2], gi[2];
#pragma unroll
            for (int n = 0; n < 2; ++n) {
                gv[n] = *(const f32x4*)(gate + (size_t)b * 6144 + c + 4 * n);
                gs[n] = *(const f32x4*)(gn + c + 4 * n);
                if (scn) gs[n] = gs[n] * (*(const f32x4*)(scn + (size_t)b * 6144 + c + 4 * n) + 1.0f);
                gi[n] = (f32x4){1.f, 1.f, 1.f, 1.f};
                if (Hin) { const f32x4 t = *(const f32x4*)(gin + c + 4 * n) * (*(const f32x4*)(scin + (size_t)b * 6144 + c + 4 * n) + 1.0f);
                    gi[n] = (f32x4){1.0f / t[0], 1.0f / t[1], 1.0f / t[2], 1.0f / t[3]}; }
            }
#pragma unroll
            for (int ai = 0; ai < 2; ++ai)
#pragma unroll
                for (int m = 0; m < 4; ++m) { const int rl = ai * HALF + wr * 64 + m * 16 + fr; const size_t off = (size_t)rl * 1024 + c;
                    f32x4 x0, x1;
                    if (Hin) { const u32x4 hv = *(const u32x4*)(Hin + hrow + off);
                        x0 = (f32x4){__uint_as_float(hv.x << 16), __uint_as_float(hv.x & 0xffff0000u), __uint_as_float(hv.y << 16), __uint_as_float(hv.y & 0xffff0000u)} * gi[0];
                        x1 = (f32x4){__uint_as_float(hv.z << 16), __uint_as_float(hv.z & 0xffff0000u), __uint_as_float(hv.w << 16), __uint_as_float(hv.w & 0xffff0000u)} * gi[1]; }
                    else { x0 = *(const f32x4*)(base + off); x1 = *(const f32x4*)(base + off + 4); }
                    const f32x4 o0 = x0 + gv[0] * acc[ai][bj][m][0], o1 = x1 + gv[1] * acc[ai][bj][m][1];
                    ss[ai * 4 + m] += (o0[0] * o0[0] + o0[1] * o0[1]) + (o0[2] * o0[2] + o0[3] * o0[3]) + (o1[0] * o1[0] + o1[1] * o1[1]) + (o1[2] * o1[2] + o1[3] * o1[3]);
                    const f32x4 h0 = o0 * gs[0], h1 = o1 * gs[1];
                    u32x4 w; w.x = cvt_pk_bf16(h0[0], h0[1]); w.y = cvt_pk_bf16(h0[2], h0[3]); w.z = cvt_pk_bf16(h1[0], h1[1]); w.w = cvt_pk_bf16(h1[2], h1[3]);
                    *(u32x4*)(Hn + hrow + off) = w;
                }
            asm volatile("" ::: "memory");
        }
#pragma unroll
        for (int ai = 0; ai < 2; ++ai)
#pragma unroll
            for (int m = 0; m < 4; ++m) { float s = ss[ai * 4 + m]; s += __shfl_xor(s, 16); s += __shfl_xor(s, 32);
                if (fq == 0) __hip_atomic_fetch_add(rowsq + u.pm * BM + ai * HALF + wr * 64 + m * 16 + fr, s, __ATOMIC_RELAXED, __HIP_MEMORY_SCOPE_AGENT); }
    }
};

template <class Epi, class Sched, bool ALIGN_EPI = false, bool SP2 = false>
__device__ __forceinline__ void gemm_phase(PG8_LAS unsigned char* lds, const Gemm g, const Sched& S, const Epi& E) {
    const int tid = opaque_tid(), wid = __builtin_amdgcn_readfirstlane(tid >> 6), lane = tid & 63, wr = wid >> 2, wc = wid & 3, fr = lane & 15, fq = lane >> 4;
    const int K = g.K, nt = K / BK;
    unsigned voffA[2], voffB[2];
#pragma unroll
    for (int i = 0; i < 2; ++i) { int R, C; stage_rc(tid * 16 + i * 8192, R, C); const int Rb = Epi::PERM ? ((R & ~31) + perm32(R & 31)) : R;
        voffA[i] = (unsigned)(R * K + C) * 2u; voffB[i] = (unsigned)(Rb * K + C) * 2u; }
    const size_t kstep = (size_t)(BK * 2);
    const size_t hstep = (size_t)HALF * K * 2;
    const size_t tstep = 2 * hstep;
    const unsigned ldsw = (unsigned)wid * 1024u;
    const int aoff = lds_byte(wr * 64 + fr, fq * 8), boff = lds_byte(wc * 32 + fr, fq * 8);
#define PG8_SA(b, h) (((b) * 2 + (h)) * HTB)
#define PG8_SB(b, h) ((4 + (b) * 2 + (h)) * HTB)
#define PG8_STAGE(bufoff, gbase, voff) do { _Pragma("unroll") for (int _i = 0; _i < 2; ++_i) \
        __builtin_amdgcn_global_load_lds((const unsigned*)((const char*)(gbase) + (voff)[_i]), (PG8_LAS unsigned*)(lds + (bufoff) + ldsw + _i * 8192), 16, 0, 0); } while (0)
#define PG8_LDA(dst, b, h) do { _Pragma("unroll") for (int m = 0; m < 4; ++m) _Pragma("unroll") for (int k = 0; k < 2; ++k) dst[m][k] = *(const PG8_LAS bf16x8*)(lds + PG8_SA(b, h) + aoff + m * 2048 + k * 1024); } while (0)
#define PG8_LDB(dst, b, h) do { _Pragma("unroll") for (int n = 0; n < 2; ++n) _Pragma("unroll") for (int k = 0; k < 2; ++k) dst[n][k] = *(const PG8_LAS bf16x8*)(lds + PG8_SB(b, h) + boff + n * 2048 + k * 1024); } while (0)
#define PG8_MMA(ai, bj, At, Bt) do { __builtin_amdgcn_s_setprio(1); _Pragma("unroll") for (int m = 0; m < 4; ++m) _Pragma("unroll") for (int n = 0; n < 2; ++n) _Pragma("unroll") for (int k = 0; k < 2; ++k) \
        acc[ai][bj][m][n] = __builtin_amdgcn_mfma_f32_16x16x32_bf16(Bt[n][k], At[m][k], acc[ai][bj][m][n], 0, 0, 0); __builtin_amdgcn_s_setprio(0); } while (0)
#define PG8_WAIT_V(n) asm volatile("s_waitcnt vmcnt(" #n ")" ::: "memory")
#define PG8_WAIT_L(n) asm volatile("s_waitcnt lgkmcnt(" #n ")" ::: "memory")
#define PG8_BAR __builtin_amdgcn_s_barrier()
#define PG8_SCHED __builtin_amdgcn_sched_barrier(0)
    Unit cur, nxt; int ui = 0;
    if (!S.next(0, cur)) return;
    f32x4 acc[2][2][4][2];
#pragma unroll
    for (int a = 0; a < 2; ++a)
#pragma unroll
        for (int b = 0; b < 2; ++b)
#pragma unroll
            for (int m = 0; m < 4; ++m)
#pragma unroll
                for (int n = 0; n < 2; ++n) acc[a][b][m][n] = (f32x4){0.f, 0.f, 0.f, 0.f};
    bf16x8 At[4][2], B0[2][2], B1[2][2];
    const char* cA = (const char*)g.A + (size_t)cur.pm * tstep; const char* cB = (const char*)g.Bt + (size_t)cur.pn * tstep;
    S.a_ready(cur);
    if constexpr (SP2) {
        PG8_STAGE(PG8_SB(0, 0), cB, voffB); PG8_STAGE(PG8_SB(0, 1), cB + hstep, voffB); PG8_STAGE(PG8_SA(0, 0), cA, voffA); PG8_STAGE(PG8_SA(0, 1), cA + hstep, voffA);
        if (wr == 1) PG8_BAR;
        PG8_WAIT_V(2); PG8_BAR;
        PG8_STAGE(PG8_SB(1, 0), cB + kstep, voffB); PG8_STAGE(PG8_SA(1, 0), cA + kstep, voffA); PG8_STAGE(PG8_SB(1, 1), cB + hstep + kstep, voffB);
        PG8_WAIT_V(6); PG8_BAR;
    } else {
        PG8_STAGE(PG8_SB(0, 0), cB, voffB); PG8_STAGE(PG8_SA(0, 0), cA, voffA); PG8_STAGE(PG8_SB(0, 1), cB + hstep, voffB); PG8_STAGE(PG8_SA(0, 1), cA + hstep, voffA);
        if (wr == 1) PG8_BAR;
        PG8_WAIT_V(4); PG8_BAR;
        PG8_STAGE(PG8_SB(1, 0), cB + kstep, voffB); PG8_STAGE(PG8_SA(1, 0), cA + kstep, voffA); PG8_STAGE(PG8_SB(1, 1), cB + hstep + kstep, voffB);
        PG8_WAIT_V(6); PG8_BAR;
    }
    for (;;) {
        const bool has_next = S.next(ui + 1, nxt);
        const char* nA = has_next ? (const char*)g.A + (size_t)nxt.pm * tstep : cA; const char* nB = has_next ? (const char*)g.Bt + (size_t)nxt.pn * tstep : cB;
        for (int t = 0; t < nt; t += 2) {
            const bool last = (t == nt - 2);
            const char* a1 = cA + (size_t)(t + 1) * kstep;
            const char* a2 = last ? nA : cA + (size_t)(t + 2) * kstep; const char* b2 = last ? nB : cB + (size_t)(t + 2) * kstep;
            const char* a3 = a2 + kstep; const char* b3 = b2 + kstep;
            if (last && has_next) S.a_ready(nxt);
            if constexpr (SP2) {
            PG8_LDB(B0, 0, 0); PG8_LDB(B1, 0, 1); PG8_SCHED; PG8_LDA(At, 0, 0); PG8_STAGE(PG8_SA(1, 1), a1 + hstep, voffA);
            PG8_WAIT_V(8); PG8_WAIT_L(0); PG8_BAR; PG8_MMA(0, 0, At, B0); PG8_MMA(0, 1, At, B1); PG8_BAR; PG8_SCHED;
            PG8_LDA(At, 0, 1); PG8_STAGE(PG8_SB(0, 0), b2, voffB); PG8_STAGE(PG8_SB(0, 1), b2 + hstep, voffB); PG8_STAGE(PG8_SA(0, 0), a2, voffA);
            PG8_WAIT_V(8); PG8_WAIT_L(0); PG8_BAR; PG8_MMA(1, 0, At, B0); PG8_MMA(1, 1, At, B1); PG8_BAR; PG8_SCHED;
            PG8_LDB(B0, 1, 0); PG8_LDB(B1, 1, 1); PG8_SCHED; PG8_LDA(At, 1, 0); PG8_STAGE(PG8_SA(0, 1), a2 + hstep, voffA);
            PG8_WAIT_V(8); PG8_WAIT_L(0); PG8_BAR; PG8_MMA(0, 0, At, B0); PG8_MMA(0, 1, At, B1); PG8_BAR; PG8_SCHED;
            PG8_LDA(At, 1, 1); PG8_STAGE(PG8_SB(1, 0), b3, voffB); PG8_STAGE(PG8_SB(1, 1), b3 + hstep, voffB); PG8_STAGE(PG8_SA(1, 0), a3, voffA);
            PG8_WAIT_V(8); PG8_WAIT_L(0); PG8_BAR; PG8_MMA(1, 0, At, B0); PG8_MMA(1, 1, At, B1); PG8_BAR; PG8_SCHED;
            } else {
            PG8_LDB(B0, 0, 0); PG8_SCHED; PG8_LDA(At, 0, 0); PG8_STAGE(PG8_SA(1, 1), a1 + hstep, voffA);
            PG8_WAIT_L(8); PG8_BAR; PG8_WAIT_L(0); PG8_MMA(0, 0, At, B0); PG8_BAR; PG8_SCHED;
            PG8_LDB(B1, 0, 1); PG8_STAGE(PG8_SB(0, 0), b2, voffB);
            PG8_BAR; PG8_WAIT_L(0); PG8_MMA(0, 1, At, B1); PG8_BAR;
            PG8_LDA(At, 0, 1); PG8_STAGE(PG8_SA(0, 0), a2, voffA);
            PG8_BAR; PG8_WAIT_L(0); PG8_MMA(1, 0, At, B0); PG8_BAR; PG8_SCHED;
            PG8_STAGE(PG8_SB(0, 1), b2 + hstep, voffB);
            PG8_WAIT_V(6); PG8_BAR; PG8_MMA(1, 1, At, B1); PG8_BAR;
            PG8_LDB(B0, 1, 0); PG8_SCHED; PG8_LDA(At, 1, 0); PG8_STAGE(PG8_SA(0, 1), a2 + hstep, voffA);
            PG8_WAIT_L(8); PG8_BAR; PG8_WAIT_L(0); PG8_MMA(0, 0, At, B0); PG8_BAR; PG8_SCHED;
            PG8_LDB(B1, 1, 1); PG8_STAGE(PG8_SB(1, 0), b3, voffB);
            PG8_BAR; PG8_WAIT_L(0); PG8_MMA(0, 1, At, B1); PG8_BAR;
            PG8_LDA(At, 1, 1); PG8_STAGE(PG8_SA(1, 0), a3, voffA);
            PG8_BAR; PG8_WAIT_L(0); PG8_MMA(1, 0, At, B0); PG8_BAR; PG8_SCHED;
            PG8_STAGE(PG8_SB(1, 1), b3 + hstep, voffB);
            PG8_WAIT_V(6); PG8_BAR; PG8_MMA(1, 1, At, B1); PG8_BAR;
            }
        }
        if constexpr (ALIGN_EPI) { if (wr == 0) PG8_BAR; }
        if constexpr (!Epi::AFTER_DRAIN) { E(acc, cur, wr, wc, fr, fq); S.done(cur); }
        if (!has_next) break;
#pragma unroll
        for (int a = 0; a < 2; ++a)
#pragma unroll
            for (int b = 0; b < 2; ++b)
#pragma unroll
                for (int m = 0; m < 4; ++m)
#pragma unroll
                    for (int n = 0; n < 2; ++n) acc[a][b][m][n] = (f32x4){0.f, 0.f, 0.f, 0.f};
        cur = nxt; cA = nA; cB = nB; ++ui;
        if constexpr (ALIGN_EPI) { if (wr == 1) PG8_BAR; }
    }
    PG8_WAIT_V(0);
    if constexpr (!ALIGN_EPI) { if (wr == 0) PG8_BAR; }
    PG8_BAR;
    if constexpr (Epi::AFTER_DRAIN) { E.fused(acc, cur, wr, wc, fr, fq, lds, wid, lane); S.done(cur); }
#undef PG8_SA
#undef PG8_SB
#undef PG8_STAGE
#undef PG8_LDA
#undef PG8_LDB
#undef PG8_MMA
#undef PG8_WAIT_V
#undef PG8_WAIT_L
#undef PG8_BAR
#undef PG8_SCHED
}
}

#define LAS __attribute__((address_space(3)))
typedef unsigned short bf16_t;
typedef short bf16x8 __attribute__((ext_vector_type(8)));
typedef short bf16x4 __attribute__((ext_vector_type(4)));
typedef float f32x4 __attribute__((ext_vector_type(4)));
typedef float f32x2 __attribute__((ext_vector_type(2)));
typedef unsigned u32x4 __attribute__((ext_vector_type(4)));
typedef unsigned u32x2 __attribute__((ext_vector_type(2)));
typedef short v4i16_t __attribute__((ext_vector_type(4)));

constexpr int NW = 8, NTHR = 512;
constexpr int DM = 1024, TP = 32768, TT = 98304, PROJ = 2304, DFF = 4096, NB = 10;
constexpr float EPS = 1e-6f;
constexpr size_t MiB = 1u << 20;
constexpr size_t WS_WIN = 0, WS_WOUT = 9 * MiB, WS_WUP = 13 * MiB, WS_WDOWN = 29 * MiB;
constexpr size_t WS_MOD = 45 * MiB, WS_ROPE = 46 * MiB, WS_PWT = 47 * MiB, WS_SGUW = 47 * MiB + 512 * 1024;
constexpr size_t WS_ML2 = 48 * MiB, WS_ML3 = 54 * MiB;
constexpr size_t WS_SHW = 45 * MiB + 512 * 1024;
constexpr size_t WS_BAR = 63 * MiB;
constexpr size_t WS_ROWSQ = 61 * MiB;
constexpr size_t WS_H = 64 * MiB, WS_OP2 = 64 * MiB, WS_OP3 = 160 * MiB;
constexpr size_t WS_U = 256 * MiB, WS_Z = 256 * MiB, WS_Y = 688 * MiB, WS_END = 1024 * MiB;
constexpr int LDS_BYTES = 147456;

struct Args {
    const float *x_p, *x_s, *c_p, *c_s, *w_ada, *b_ada, *g_mix, *g_mlp, *w_in, *pool_w, *pool_scale, *sgu_w, *sgu_b, *w_out, *w_up, *w_down, *g_final;
    float* out; unsigned char* ws; int ph_lo, ph_hi;
};

__device__ __forceinline__ unsigned pk_bf16(float lo, float hi) { return pg8::cvt_pk_bf16(lo, hi); }
__device__ __forceinline__ float bf_lo(unsigned w) { return __uint_as_float(w << 16); }
__device__ __forceinline__ float bf_hi(unsigned w) { return __uint_as_float(w & 0xffff0000u); }
__device__ __forceinline__ bf16x4 tr4(const LAS unsigned char* p) { return __builtin_bit_cast(bf16x4, __builtin_amdgcn_ds_read_tr16_b64_v4i16((LAS v4i16_t*)p)); }
__device__ __forceinline__ f32x4 mfma32(bf16x8 a, bf16x8 b, f32x4 c) { return __builtin_amdgcn_mfma_f32_16x16x32_bf16(a, b, c, 0, 0, 0); }
__device__ __forceinline__ f32x4 mfma16(bf16x4 a, bf16x4 b, f32x4 c) { return __builtin_amdgcn_mfma_f32_16x16x16bf16_1k(a, b, c, 0, 0, 0); }
__device__ __forceinline__ float wave_sum(float v) {
#pragma unroll
    for (int o = 1; o < 64; o <<= 1) v += __shfl_xor(v, o);
    return v;
}
__device__ __forceinline__ void row_info(int row, int& b, int& rb, int& S) {
    if (row < TP) { b = row >> 14; rb = b << 14; S = 16384; } else { const int q = (row - TP) >> 13; b = 2 + q; rb = TP + (q << 13); S = 8192; }
}

__device__ __forceinline__ unsigned f2bf(float f) { unsigned u = __builtin_bit_cast(unsigned, f); return (u + 0x7fffu + ((u >> 16) & 1u)) >> 16; }
__device__ __forceinline__ unsigned pk2(float lo, float hi) { return f2bf(lo) | (f2bf(hi) << 16); }
__device__ __forceinline__ void p0_transpose_item(const float* W, int K, int N, bf16_t* WT, LAS float* scr, int item, int lane) {
    const int nblk = N / 32, kb = item / nblk, nb = item % nblk, k0 = 64 * kb, n0 = 32 * nb;
#pragma unroll 8
    for (int i = 0; i < 32; ++i) { const int kk = 2 * i + (lane >> 5); scr[kk * 33 + (lane & 31)] = W[(size_t)(k0 + kk) * N + n0 + (lane & 31)]; }
    asm volatile("s_waitcnt lgkmcnt(0)" ::: "memory");
    const int c = lane & 7;
#pragma unroll
    for (int j = 0; j < 4; ++j) { const int n = (lane >> 3) + 8 * j; const LAS float* s = scr + (8 * c) * 33 + n;
        u32x4 o; o.x = pk2(s[0 * 33], s[1 * 33]); o.y = pk2(s[2 * 33], s[3 * 33]); o.z = pk2(s[4 * 33], s[5 * 33]); o.w = pk2(s[6 * 33], s[7 * 33]);
        *(u32x4*)(WT + (size_t)(n0 + n) * K + k0 + 8 * c) = o; }
    asm volatile("s_waitcnt lgkmcnt(0)" ::: "memory");
}
__device__ __forceinline__ void p0_prologue(const Args& A, LAS unsigned char* lds) {
    const int tid = opaque_tid(), lane = tid & 63, wave = tid >> 6, G = gridDim.x;
    unsigned char* ws = A.ws;
    {
        LAS float* cact = (LAS float*)lds;
        LAS float* red = (LAS float*)(lds + 40960);
        float* mod = (float*)(ws + WS_MOD);
        bool have = false;
        for (int it = blockIdx.x; it < 192; it += G) {
            if (!have) {
                for (int i = tid; i < NB * DM; i += NTHR) { const int b = i >> 10, k = i & 1023; const float c = (b < 2) ? A.c_p[b * DM + k] : A.c_s[(b - 2) * DM + k];
                    cact[i] = c / (1.0f + __expf(-c)); }
                have = true;
            }
            __syncthreads();
            const int l = it / 96, c0 = (it % 96) * 64, col = c0 + lane, kg = wave;
            float acc[NB];
#pragma unroll
            for (int b = 0; b < NB; ++b) acc[b] = 0.f;
            const float* wp = A.w_ada + ((size_t)l * DM + kg * 128) * 6144 + col;
#pragma unroll 4
            for (int k = 0; k < 128; ++k) { const float w = wp[(size_t)k * 6144];
#pragma unroll
                for (int b = 0; b < NB; ++b) acc[b] += cact[b * DM + kg * 128 + k] * w; }
#pragma unroll
            for (int b = 0; b < NB; ++b) red[(kg * NB + b) * 64 + lane] = acc[b];
            __syncthreads();
            for (int i = tid; i < NB * 64; i += NTHR) { const int b = i >> 6, cc = i & 63; float s = A.b_ada[(size_t)l * 6144 + c0 + cc];
#pragma unroll
                for (int g = 0; g < 8; ++g) s += red[(g * NB + b) * 64 + cc];
                mod[((size_t)l * NB + b) * 6144 + c0 + cc] = s; }
        }
        __syncthreads();
    }
    {
        LAS float* scr = (LAS float*)(lds + wave * 16384);
        const int gw = blockIdx.x * NW + wave, NGW = G * NW;
        constexpr int I_IN = (DM / 64) * (PROJ / 32), I_OUT = (DM / 64) * (DM / 32), I_UP = (DM / 64) * (DFF / 32), I_DN = (DFF / 64) * (DM / 32);
        constexpr int PER_L = I_IN + I_OUT + I_UP + I_DN;
        for (int it = gw; it < 2 * PER_L; it += NGW) {
            const int l = it / PER_L; int r = it % PER_L;
            if (r < I_IN) { p0_transpose_item(A.w_in + (size_t)l * DM * PROJ, DM, PROJ, (bf16_t*)(ws + WS_WIN) + (size_t)l * PROJ * DM, scr, r, lane); continue; } r -= I_IN;
            if (r < I_OUT) { p0_transpose_item(A.w_out + (size_t)l * DM * DM, DM, DM, (bf16_t*)(ws + WS_WOUT) + (size_t)l * DM * DM, scr, r, lane); continue; } r -= I_OUT;
            if (r < I_UP) { p0_transpose_item(A.w_up + (size_t)l * DM * DFF, DM, DFF, (bf16_t*)(ws + WS_WUP) + (size_t)l * DFF * DM, scr, r, lane); continue; } r -= I_UP;
            p0_transpose_item(A.w_down + (size_t)l * DFF * DM, DFF, DM, (bf16_t*)(ws + WS_WDOWN) + (size_t)l * DM * DFF, scr, r, lane);
        }
    }
    const int gt = blockIdx.x * NTHR + tid, NGT = G * NTHR;
    {
        float* rope = (float*)(ws + WS_ROPE);
        for (int e = gt; e < 16384 * 8; e += NGT) {
            const int pos = e >> 3, i = e & 7;
            float fi = 1.0f;
            fi = (i == 1) ? 0.1939227432012558f : fi; fi = (i == 2) ? 0.03760603070259094f : fi; fi = (i == 3) ? 0.007292664609849453f : fi; fi = (i == 4) ? 0.0014142135623842478f : fi;
            fi = (i == 5) ? 0.00027424818836152554f : fi; fi = (i == 6) ? 5.318296098266728e-05f : fi; fi = (i == 7) ? 1.0313386155758053e-05f : fi;
            const float angf = (float)pos * fi;
            const double ang = (double)angf;
            const double TWO_PI = 6.283185307179586476925286766559;
            const double r = ang - TWO_PI * rint(ang / TWO_PI);
            const double r2 = r * r;
            double sn = 0.0, cn = 0.0, ts = r, tc = 1.0;
#pragma unroll 1
            for (int k = 0; k < 14; ++k) { sn += ts; cn += tc; tc = -tc * r2 / (double)((2 * k + 1) * (2 * k + 2)); ts = -ts * r2 / (double)((2 * k + 2) * (2 * k + 3)); }
            rope[2 * e] = (float)cn; rope[2 * e + 1] = (float)sn;
        }
    }
    if (blockIdx.x == 0) { unsigned* bz = (unsigned*)(ws + WS_BAR); for (int e = tid; e < 3456; e += NTHR) bz[e] = 0u; }
    { float* rz = (float*)(ws + WS_ROWSQ) + TT; for (int e = gt; e < 4 * TT; e += NGT) rz[e] = 0.f; }
    {
        bf16_t* pwt = (bf16_t*)(ws + WS_PWT);
        for (int e = gt; e < 2 * 4 * 64 * 64; e += NGT) { const int c = e & 63, d = (e >> 6) & 63, lg = e >> 12; pwt[e] = (bf16_t)f2bf(A.pool_w[(size_t)lg * 4096 + c * 64 + d]); }
        bf16_t* sw = (bf16_t*)(ws + WS_SGUW);
        for (int e = gt; e < 2 * 4 * 128 * 128; e += NGT) sw[e] = (bf16_t)f2bf(A.sgu_w[e]);
    }
}

__device__ __forceinline__ void prep_phase(const float* xp, const float* xs, const float* g, const float* mod0, bf16_t* H, float* rowsq0, const float* mod, const bf16_t* win_t, const bf16_t* wup_t, float* shw) {
    const int tid = opaque_tid(), lane = tid & 63, wave = tid >> 6;
    const int gw = blockIdx.x * NW + wave, NGW = gridDim.x * NW;
    {
        for (int t = gw; t < 2 * 6400; t += NGW) {
            const int l = t / 6400, r = t - l * 6400; const bool up = (r >= 2304); const int n = up ? r - 2304 : r;
            const bf16_t* wrow = (up ? wup_t + (size_t)l * DFF * DM : win_t + (size_t)l * PROJ * DM) + (size_t)n * DM;
            const u32x4 w0 = *(const u32x4*)(wrow + 8 * lane), w1 = *(const u32x4*)(wrow + 512 + 8 * lane);
            const float wf[16] = {bf_lo(w0.x), bf_hi(w0.x), bf_lo(w0.y), bf_hi(w0.y), bf_lo(w0.z), bf_hi(w0.z), bf_lo(w0.w), bf_hi(w0.w),
                                  bf_lo(w1.x), bf_hi(w1.x), bf_lo(w1.y), bf_hi(w1.y), bf_lo(w1.z), bf_hi(w1.z), bf_lo(w1.w), bf_hi(w1.w)};
            const float* shb = mod + (size_t)l * NB * 6144 + (up ? 3072 : 0);
            float* dst = shw + (size_t)l * (NB * 6400) + (up ? NB * 2304 : 0);
            const int ldn = up ? 4096 : 2304;
#pragma unroll 2
            for (int b = 0; b < NB; ++b) {
                const float* sp = shb + (size_t)b * 6144;
                const f32x4 s0 = *(const f32x4*)(sp + 8 * lane), s1 = *(const f32x4*)(sp + 8 * lane + 4), s2 = *(const f32x4*)(sp + 512 + 8 * lane), s3 = *(const f32x4*)(sp + 512 + 8 * lane + 4);
                float a = (s0[0] * wf[0] + s0[1] * wf[1]) + (s0[2] * wf[2] + s0[3] * wf[3]) + (s1[0] * wf[4] + s1[1] * wf[5]) + (s1[2] * wf[6] + s1[3] * wf[7])
                        + (s2[0] * wf[8] + s2[1] * wf[9]) + (s2[2] * wf[10] + s2[3] * wf[11]) + (s3[0] * wf[12] + s3[1] * wf[13]) + (s3[2] * wf[14] + s3[3] * wf[15]);
                a = wave_sum(a);
                if (lane == 0) dst[(size_t)b * ldn + n] = a;
            }
        }
    }
    const int per = (TT + NGW - 1) / NGW;
    const int r0 = gw * per, r1 = (r0 + per < TT) ? r0 + per : TT;
    int curb = -1; f32x4 gs[4];
    for (int row = r0; row < r1; ++row) {
        int b, rb, S; row_info(row, b, rb, S);
        if (b != curb) { curb = b;
#pragma unroll
            for (int j = 0; j < 4; ++j) { const int c = 4 * lane + 256 * j; gs[j] = *(const f32x4*)(g + c) * (*(const f32x4*)(mod0 + (size_t)b * 6144 + 1024 + c) + 1.0f); } }
        const float* xr = (row < TP) ? xp + (size_t)row * DM : xs + (size_t)(row - TP) * DM;
        f32x4 v[4]; float s = 0.f;
#pragma unroll
        for (int j = 0; j < 4; ++j) { v[j] = *(const f32x4*)(xr + 4 * lane + 256 * j); s += (v[j].x * v[j].x + v[j].y * v[j].y) + (v[j].z * v[j].z + v[j].w * v[j].w); }
        s = wave_sum(s);
        if (lane == 0) rowsq0[row] = s;
        bf16_t* hr = H + (size_t)row * DM;
#pragma unroll
        for (int j = 0; j < 4; ++j) { const f32x4 o = v[j] * gs[j]; u32x2 w; w.x = pk_bf16(o.x, o.y); w.y = pk_bf16(o.z, o.w); *(u32x2*)(hr + 4 * lane + 256 * j) = w; }
    }
}
__device__ __forceinline__ void final_norm_phase(float* X, const bf16_t* H, const float* rowsq) {
    const int tid = opaque_tid(), lane = tid & 63, wave = tid >> 6;
    const int gw = blockIdx.x * NW + wave, NGW = gridDim.x * NW;
    const int per = (TT + NGW - 1) / NGW;
    const int r0 = gw * per, r1 = (r0 + per < TT) ? r0 + per : TT;
    for (int row = r0; row < r1; ++row) {
        float* xr = X + (size_t)row * DM; const bf16_t* hr = H + (size_t)row * DM;
        const float r = 1.0f / sqrtf(rowsq[row] * (1.0f / DM) + EPS);
#pragma unroll
        for (int j = 0; j < 2; ++j) { const u32x4 hv = *(const u32x4*)(hr + 8 * lane + 512 * j);
            *(f32x4*)(xr + 8 * lane + 512 * j) = (f32x4){bf_lo(hv.x), bf_hi(hv.x), bf_lo(hv.y), bf_hi(hv.y)} * r;
            *(f32x4*)(xr + 8 * lane + 512 * j + 4) = (f32x4){bf_lo(hv.z), bf_hi(hv.z), bf_lo(hv.w), bf_hi(hv.w)} * r; }
    }
}

constexpr int KSTR = 144, VSTR = 160, ATT_V_OFF = 256 * KSTR;
struct AttnCur { int qtok, f0, Ld; };
__device__ __forceinline__ void attn_load(const bf16_t* Z, int au, int d, int tid, u32x4 (&kr)[4], u32x4 (&vr)[4], bf16x8 (&qf)[2], AttnCur& c, int& hh) {
    const int lane = tid & 63, w = tid >> 6, fr = lane & 15, fq = lane >> 4;
    const int h = au & 7, blk = au >> 3;
    int b, rb, S; row_info(blk * 128, b, rb, S);
    const int lb = (blk * 128 - rb) >> 7, nfb = S / (128 * d);
    const int rho = lb / nfb, f0 = (lb % nfb) * 128, Ld = S / d;
#pragma unroll
    for (int it = 0; it < 4; ++it) {
        const int idx = tid + NTHR * it, row = idx >> 3, ch = idx & 7, fk = f0 - 64 + row;
        u32x4 kv = {0u, 0u, 0u, 0u}, vv = {0u, 0u, 0u, 0u};
        if (fk >= 0 && fk < Ld) { const bf16_t* zr = Z + (size_t)(rb + fk * d + rho) * PROJ + h * 64 + ch * 8; kv = *(const u32x4*)(zr + 768); vv = *(const u32x4*)(zr + 1280); }
        kr[it] = kv; vr[it] = vv;
    }
    c.qtok = rb + (f0 + 16 * w + fr) * d + rho; c.f0 = f0; c.Ld = Ld; hh = h;
#pragma unroll
    for (int kk = 0; kk < 2; ++kk) qf[kk] = *(const bf16x8*)(Z + (size_t)c.qtok * PROJ + 256 + h * 64 + 8 * fq + 32 * kk);
}
template <bool FINAL>
__device__ __forceinline__ void attn_phase1(LAS unsigned char* lds, const bf16_t* Z, int d, bf16_t* OP, f32x2* ML, const bf16_t* OP2, const bf16_t* OP3, const f32x2* ML2, const f32x2* ML3, bf16_t* Y) {
    const int tid = opaque_tid(), lane = tid & 63, w = tid >> 6, fr = lane & 15, fq = lane >> 4, G = gridDim.x;
    constexpr int NU = 6144;
    u32x4 kr[4], vr[4]; bf16x8 qn[2]; AttnCur cn; int hn;
    int au = blockIdx.x;
    if (au >= NU) return;
    attn_load(Z, au, d, tid, kr, vr, qn, cn, hn);
    for (; au < NU; au += G) {
#pragma unroll
        for (int it = 0; it < 4; ++it) { const int idx = tid + NTHR * it, row = idx >> 3, ch = idx & 7;
            *(LAS u32x4*)(lds + row * KSTR + ch * 16) = kr[it]; *(LAS u32x4*)(lds + ATT_V_OFF + row * VSTR + ch * 16) = vr[it]; }
        const AttnCur c = cn; const int h = hn; bf16x8 qf[2] = {qn[0], qn[1]};
        __syncthreads();
        u32x2 o2[4], o3[4]; f32x2 a2, a3;
        if (FINAL) {
            a2 = ML2[(size_t)c.qtok * 8 + h]; a3 = ML3[(size_t)c.qtok * 8 + h];
            const bf16_t* p2 = OP2 + (size_t)c.qtok * 512 + h * 64 + 4 * fq; const bf16_t* p3 = OP3 + (size_t)c.qtok * 512 + h * 64 + 4 * fq;
#pragma unroll
            for (int dd = 0; dd < 4; ++dd) { o2[dd] = *(const u32x2*)(p2 + 16 * dd); o3[dd] = *(const u32x2*)(p3 + 16 * dd); }
        }
        { const int an = (au + G < NU) ? au + G : au; attn_load(Z, an, d, tid, kr, vr, qn, cn, hn); }
        f32x4 st[9];
        {
            bf16x8 kf[18];
#pragma unroll
            for (int t = 0; t < 9; ++t)
#pragma unroll
                for (int kk = 0; kk < 2; ++kk) kf[2 * t + kk] = *(const LAS bf16x8*)(lds + (16 * w + 16 * t + fr) * KSTR + (8 * fq + 32 * kk) * 2);
            asm volatile("s_waitcnt lgkmcnt(0)" ::: "memory");
            __builtin_amdgcn_sched_barrier(0);
#pragma unroll
            for (int t = 0; t < 9; ++t) { st[t] = mfma32(kf[2 * t], qf[0], (f32x4){0.f, 0.f, 0.f, 0.f}); }
#pragma unroll
            for (int t = 0; t < 9; ++t) { st[t] = mfma32(kf[2 * t + 1], qf[1], st[t]); }
        }
        const int tg = lane >> 4, tq = (lane >> 2) & 3, tp = lane & 3;
        const LAS unsigned char* vb = lds + ATT_V_OFF + (16 * w + 4 * tg + tq) * VSTR + tp * 8;
        bf16x4 vlo[2][4], vhi[2][4];
#pragma unroll
        for (int ks = 0; ks < 2; ++ks)
#pragma unroll
            for (int dd = 0; dd < 4; ++dd) { vlo[ks][dd] = tr4(vb + (32 * ks) * VSTR + dd * 32); vhi[ks][dd] = tr4(vb + (32 * ks + 16) * VSTR + dd * 32); }
        __builtin_amdgcn_sched_barrier(0);
        float mx = -1e30f;
        const int fkb = c.f0 + 16 * w - 64;
#pragma unroll
        for (int j = 0; j < 4; ++j) { if (4 * fq + j < fr) st[0][j] = -1e30f; if (4 * fq + j > fr) st[8][j] = -1e30f; }
        if ((fkb < 0) || (fkb + 144 > c.Ld)) {
#pragma unroll
            for (int t = 0; t < 9; ++t)
#pragma unroll
                for (int j = 0; j < 4; ++j) { const int fk = fkb + 16 * t + 4 * fq + j; if (fk < 0 || fk >= c.Ld) st[t][j] = -1e30f; }
        }
#pragma unroll
        for (int t = 0; t < 9; ++t) mx = fmaxf(mx, fmaxf(fmaxf(st[t][0], st[t][1]), fmaxf(st[t][2], st[t][3])));
        mx = fmaxf(mx, __shfl_xor(mx, 16)); mx = fmaxf(mx, __shfl_xor(mx, 32));
        float lsum = 0.f;
#pragma unroll
        for (int t = 0; t < 9; ++t)
#pragma unroll
            for (int j = 0; j < 4; ++j) { const float p = __builtin_amdgcn_exp2f(st[t][j] - mx); st[t][j] = p; lsum += p; }
        lsum += __shfl_xor(lsum, 16); lsum += __shfl_xor(lsum, 32);
        f32x4 ot[4];
#pragma unroll
        for (int dd = 0; dd < 4; ++dd) ot[dd] = (f32x4){0.f, 0.f, 0.f, 0.f};
        asm volatile("s_waitcnt lgkmcnt(0)" ::: "memory");
        __builtin_amdgcn_sched_barrier(0);
#pragma unroll
        for (int ks = 0; ks < 2; ++ks) {
            u32x4 pw; pw.x = pk_bf16(st[2 * ks][0], st[2 * ks][1]); pw.y = pk_bf16(st[2 * ks][2], st[2 * ks][3]); pw.z = pk_bf16(st[2 * ks + 1][0], st[2 * ks + 1][1]); pw.w = pk_bf16(st[2 * ks + 1][2], st[2 * ks + 1][3]);
            const bf16x8 pf = __builtin_bit_cast(bf16x8, pw);
#pragma unroll
            for (int dd = 0; dd < 4; ++dd) { const bf16x4 lo = vlo[ks][dd], hi = vhi[ks][dd];
                const bf16x8 vf = {lo[0], lo[1], lo[2], lo[3], hi[0], hi[1], hi[2], hi[3]}; ot[dd] = mfma32(vf, pf, ot[dd]); }
        }
        __builtin_amdgcn_sched_barrier(0);
        {
            bf16x4 wlo[2][4], whi[2][4], vl8[4];
#pragma unroll
            for (int ks = 0; ks < 2; ++ks)
#pragma unroll
                for (int dd = 0; dd < 4; ++dd) { wlo[ks][dd] = tr4(vb + (32 * (ks + 2)) * VSTR + dd * 32); whi[ks][dd] = tr4(vb + (32 * (ks + 2) + 16) * VSTR + dd * 32); }
#pragma unroll
            for (int dd = 0; dd < 4; ++dd) vl8[dd] = tr4(vb + 128 * VSTR + dd * 32);
            asm volatile("s_waitcnt lgkmcnt(0)" ::: "memory");
            __builtin_amdgcn_sched_barrier(0);
#pragma unroll
            for (int ks = 0; ks < 2; ++ks) {
                u32x4 pw; pw.x = pk_bf16(st[2 * ks + 4][0], st[2 * ks + 4][1]); pw.y = pk_bf16(st[2 * ks + 4][2], st[2 * ks + 4][3]); pw.z = pk_bf16(st[2 * ks + 5][0], st[2 * ks + 5][1]); pw.w = pk_bf16(st[2 * ks + 5][2], st[2 * ks + 5][3]);
                const bf16x8 pf = __builtin_bit_cast(bf16x8, pw);
#pragma unroll
                for (int dd = 0; dd < 4; ++dd) { const bf16x4 lo = wlo[ks][dd], hi = whi[ks][dd];
                    const bf16x8 vf = {lo[0], lo[1], lo[2], lo[3], hi[0], hi[1], hi[2], hi[3]}; ot[dd] = mfma32(vf, pf, ot[dd]); }
            }
            u32x2 pw; pw.x = pk_bf16(st[8][0], st[8][1]); pw.y = pk_bf16(st[8][2], st[8][3]);
            const bf16x4 pf = __builtin_bit_cast(bf16x4, pw);
#pragma unroll
            for (int dd = 0; dd < 4; ++dd) ot[dd] = mfma16(vl8[dd], pf, ot[dd]);
        }
        if (!FINAL) {
            const float inv = 1.0f / lsum;
            bf16_t* op = OP + (size_t)c.qtok * 512 + h * 64 + 4 * fq;
#pragma unroll
            for (int dd = 0; dd < 4; ++dd) { u32x2 o; o.x = pk_bf16(ot[dd][0] * inv, ot[dd][1] * inv); o.y = pk_bf16(ot[dd][2] * inv, ot[dd][3] * inv); *(u32x2*)(op + 16 * dd) = o; }
            if (fq == 0) ML[(size_t)c.qtok * 8 + h] = (f32x2){mx, lsum};
        } else {
            const float M = fmaxf(mx, fmaxf(a2.x, a3.x));
            const float w1 = __builtin_amdgcn_exp2f(mx - M), w2 = a2.y * __builtin_amdgcn_exp2f(a2.x - M), w3 = a3.y * __builtin_amdgcn_exp2f(a3.x - M);
            const float inv = 1.0f / (lsum * w1 + w2 + w3);
            const float c1 = w1 * inv, c2 = w2 * inv, c3 = w3 * inv;
            bf16_t* yp = Y + (size_t)c.qtok * DM + 256 + h * 64 + 4 * fq;
#pragma unroll
            for (int dd = 0; dd < 4; ++dd) {
                const float y0 = ot[dd][0] * c1 + bf_lo(o2[dd].x) * c2 + bf_lo(o3[dd].x) * c3, y1 = ot[dd][1] * c1 + bf_hi(o2[dd].x) * c2 + bf_hi(o3[dd].x) * c3;
                const float y2 = ot[dd][2] * c1 + bf_lo(o2[dd].y) * c2 + bf_lo(o3[dd].y) * c3, y3 = ot[dd][3] * c1 + bf_hi(o2[dd].y) * c2 + bf_hi(o3[dd].y) * c3;
                u32x2 o; o.x = pk_bf16(y0, y1); o.y = pk_bf16(y2, y3); *(u32x2*)(yp + 16 * dd) = o; }
        }
        __syncthreads();
    }
}

template <bool FINAL>
__device__ __forceinline__ void attn_step(LAS unsigned char* lds, const bf16_t* Z, int d, bf16_t* OP, f32x2* ML, const bf16_t* OP2, const bf16_t* OP3, const f32x2* ML2, const f32x2* ML3, bf16_t* Y,
                                          int au, int G, int tid, u32x4 (&kr)[4], u32x4 (&vr)[4], bf16x8 (&qn)[2], AttnCur& cn, int& hn) {
    const int lane = tid & 63, w = tid >> 6, fr = lane & 15, fq = lane >> 4;
    constexpr int NU = 6144;
#pragma unroll
    for (int it = 0; it < 4; ++it) { const int idx = tid + NTHR * it, row = idx >> 3, ch = idx & 7;
        *(LAS u32x4*)(lds + row * KSTR + ch * 16) = kr[it]; *(LAS u32x4*)(lds + ATT_V_OFF + row * VSTR + ch * 16) = vr[it]; }
    const AttnCur c = cn; const int h = hn; bf16x8 qf[2] = {qn[0], qn[1]};
    __syncthreads();
    u32x2 o2[4], o3[4]; f32x2 a2, a3;
    if (FINAL) {
        const bf16_t* p2 = OP2 + (size_t)c.qtok * 512 + h * 64 + 4 * fq; const bf16_t* p3 = OP3 + (size_t)c.qtok * 512 + h * 64 + 4 * fq;
#pragma unroll
        for (int dd = 0; dd < 4; ++dd) { o2[dd] = *(const u32x2*)(p2 + 16 * dd); o3[dd] = *(const u32x2*)(p3 + 16 * dd); }
    }
    attn_load(Z, (au + 2 * G < NU) ? au + 2 * G : au, d, tid, kr, vr, qn, cn, hn);
    f32x4 st[9];
    {
        bf16x8 kf[9];
#pragma unroll
        for (int t = 0; t < 9; ++t) kf[t] = *(const LAS bf16x8*)(lds + (16 * w + 16 * t + fr) * KSTR + (8 * fq) * 2);
        asm volatile("s_waitcnt lgkmcnt(0)" ::: "memory");
        __builtin_amdgcn_sched_barrier(0);
#pragma unroll
        for (int t = 0; t < 9; ++t) { st[t] = mfma32(kf[t], qf[0], (f32x4){0.f, 0.f, 0.f, 0.f}); }
        __builtin_amdgcn_sched_barrier(0);
#pragma unroll
        for (int t = 0; t < 9; ++t) kf[t] = *(const LAS bf16x8*)(lds + (16 * w + 16 * t + fr) * KSTR + (8 * fq + 32) * 2);
        asm volatile("s_waitcnt lgkmcnt(0)" ::: "memory");
        __builtin_amdgcn_sched_barrier(0);
#pragma unroll
        for (int t = 0; t < 9; ++t) { st[t] = mfma32(kf[t], qf[1], st[t]); }
    }
    const int tg = lane >> 4, tq = (lane >> 2) & 3, tp = lane & 3;
    const LAS unsigned char* vb = lds + ATT_V_OFF + (16 * w + 4 * tg + tq) * VSTR + tp * 8;
    bf16x4 vlo[2][4], vhi[2][4];
#pragma unroll
    for (int ks = 0; ks < 2; ++ks)
#pragma unroll
        for (int dd = 0; dd < 4; ++dd) { vlo[ks][dd] = tr4(vb + (32 * ks) * VSTR + dd * 32); vhi[ks][dd] = tr4(vb + (32 * ks + 16) * VSTR + dd * 32); }
    __builtin_amdgcn_sched_barrier(0);
    float mx = -1e30f;
    const int fkb = c.f0 + 16 * w - 64;
#pragma unroll
    for (int j = 0; j < 4; ++j) { if (4 * fq + j < fr) st[0][j] = -1e30f; if (4 * fq + j > fr) st[8][j] = -1e30f; }
    if ((fkb < 0) || (fkb + 144 > c.Ld)) {
#pragma unroll
        for (int t = 0; t < 9; ++t)
#pragma unroll
            for (int j = 0; j < 4; ++j) { const int fk = fkb + 16 * t + 4 * fq + j; if (fk < 0 || fk >= c.Ld) st[t][j] = -1e30f; }
    }
#pragma unroll
    for (int t = 0; t < 9; ++t) mx = fmaxf(mx, fmaxf(fmaxf(st[t][0], st[t][1]), fmaxf(st[t][2], st[t][3])));
    mx = fmaxf(mx, __shfl_xor(mx, 16)); mx = fmaxf(mx, __shfl_xor(mx, 32));
    float lsum = 0.f;
#pragma unroll
    for (int t = 0; t < 9; ++t)
#pragma unroll
        for (int j = 0; j < 4; ++j) { const float p = __builtin_amdgcn_exp2f(st[t][j] - mx); st[t][j] = p; lsum += p; }
    lsum += __shfl_xor(lsum, 16); lsum += __shfl_xor(lsum, 32);
    f32x4 ot[4];
#pragma unroll
    for (int dd = 0; dd < 4; ++dd) ot[dd] = (f32x4){0.f, 0.f, 0.f, 0.f};
    asm volatile("s_waitcnt lgkmcnt(0)" ::: "memory");
    __builtin_amdgcn_sched_barrier(0);
#pragma unroll
    for (int ks = 0; ks < 2; ++ks) {
        u32x4 pw; pw.x = pk_bf16(st[2 * ks][0], st[2 * ks][1]); pw.y = pk_bf16(st[2 * ks][2], st[2 * ks][3]); pw.z = pk_bf16(st[2 * ks + 1][0], st[2 * ks + 1][1]); pw.w = pk_bf16(st[2 * ks + 1][2], st[2 * ks + 1][3]);
        const bf16x8 pf = __builtin_bit_cast(bf16x8, pw);
#pragma unroll
        for (int dd = 0; dd < 4; ++dd) { const bf16x4 lo = vlo[ks][dd], hi = vhi[ks][dd];
            const bf16x8 vf = {lo[0], lo[1], lo[2], lo[3], hi[0], hi[1], hi[2], hi[3]}; ot[dd] = mfma32(vf, pf, ot[dd]); }
    }
    __builtin_amdgcn_sched_barrier(0);
    {
        bf16x4 wlo[4], whi[4], vl8[4];
#pragma unroll
        for (int dd = 0; dd < 4; ++dd) { wlo[dd] = tr4(vb + (32 * 2) * VSTR + dd * 32); whi[dd] = tr4(vb + (32 * 2 + 16) * VSTR + dd * 32); }
#pragma unroll
        for (int dd = 0; dd < 4; ++dd) vl8[dd] = tr4(vb + 128 * VSTR + dd * 32);
        asm volatile("s_waitcnt lgkmcnt(0)" ::: "memory");
        __builtin_amdgcn_sched_barrier(0);
        {
            u32x4 pw; pw.x = pk_bf16(st[4][0], st[4][1]); pw.y = pk_bf16(st[4][2], st[4][3]); pw.z = pk_bf16(st[5][0], st[5][1]); pw.w = pk_bf16(st[5][2], st[5][3]);
            const bf16x8 pf = __builtin_bit_cast(bf16x8, pw);
#pragma unroll
            for (int dd = 0; dd < 4; ++dd) { const bf16x4 lo = wlo[dd], hi = whi[dd];
                const bf16x8 vf = {lo[0], lo[1], lo[2], lo[3], hi[0], hi[1], hi[2], hi[3]}; ot[dd] = mfma32(vf, pf, ot[dd]); }
            u32x2 pw2; pw2.x = pk_bf16(st[8][0], st[8][1]); pw2.y = pk_bf16(st[8][2], st[8][3]);
            const bf16x4 pf4 = __builtin_bit_cast(bf16x4, pw2);
#pragma unroll
            for (int dd = 0; dd < 4; ++dd) ot[dd] = mfma16(vl8[dd], pf4, ot[dd]);
        }
        __builtin_amdgcn_sched_barrier(0);
#pragma unroll
        for (int dd = 0; dd < 4; ++dd) { wlo[dd] = tr4(vb + (32 * 3) * VSTR + dd * 32); whi[dd] = tr4(vb + (32 * 3 + 16) * VSTR + dd * 32); }
        asm volatile("s_waitcnt lgkmcnt(0)" ::: "memory");
        __builtin_amdgcn_sched_barrier(0);
        {
            u32x4 pw; pw.x = pk_bf16(st[6][0], st[6][1]); pw.y = pk_bf16(st[6][2], st[6][3]); pw.z = pk_bf16(st[7][0], st[7][1]); pw.w = pk_bf16(st[7][2], st[7][3]);
            const bf16x8 pf = __builtin_bit_cast(bf16x8, pw);
#pragma unroll
            for (int dd = 0; dd < 4; ++dd) { const bf16x4 lo = wlo[dd], hi = whi[dd];
                const bf16x8 vf = {lo[0], lo[1], lo[2], lo[3], hi[0], hi[1], hi[2], hi[3]}; ot[dd] = mfma32(vf, pf, ot[dd]); }
        }
    }
    if (!FINAL) {
        const float inv = 1.0f / lsum;
        bf16_t* op = OP + (size_t)c.qtok * 512 + h * 64 + 4 * fq;
#pragma unroll
        for (int dd = 0; dd < 4; ++dd) { u32x2 o; o.x = pk_bf16(ot[dd][0] * inv, ot[dd][1] * inv); o.y = pk_bf16(ot[dd][2] * inv, ot[dd][3] * inv); *(u32x2*)(op + 16 * dd) = o; }
        if (fq == 0) ML[(size_t)c.qtok * 8 + h] = (f32x2){mx, lsum};
    } else {
        a2 = ML2[(size_t)c.qtok * 8 + h]; a3 = ML3[(size_t)c.qtok * 8 + h];
        const float M = fmaxf(mx, fmaxf(a2.x, a3.x));
        const float w1 = __builtin_amdgcn_exp2f(mx - M), w2 = a2.y * __builtin_amdgcn_exp2f(a2.x - M), w3 = a3.y * __builtin_amdgcn_exp2f(a3.x - M);
        const float inv = 1.0f / (lsum * w1 + w2 + w3);
        const float c1 = w1 * inv, c2 = w2 * inv, c3 = w3 * inv;
        bf16_t* yp = Y + (size_t)c.qtok * DM + 256 + h * 64 + 4 * fq;
#pragma unroll
        for (int dd = 0; dd < 4; ++dd) {
            const float y0 = ot[dd][0] * c1 + bf_lo(o2[dd].x) * c2 + bf_lo(o3[dd].x) * c3, y1 = ot[dd][1] * c1 + bf_hi(o2[dd].x) * c2 + bf_hi(o3[dd].x) * c3;
            const float y2 = ot[dd][2] * c1 + bf_lo(o2[dd].y) * c2 + bf_lo(o3[dd].y) * c3, y3 = ot[dd][3] * c1 + bf_hi(o2[dd].y) * c2 + bf_hi(o3[dd].y) * c3;
            u32x2 o; o.x = pk_bf16(y0, y1); o.y = pk_bf16(y2, y3); *(u32x2*)(yp + 16 * dd) = o; }
    }
    __syncthreads();
}
template <bool FINAL>
__device__ __forceinline__ void attn_phase(LAS unsigned char* lds, const bf16_t* Z, int d, bf16_t* OP, f32x2* ML, const bf16_t* OP2, const bf16_t* OP3, const f32x2* ML2, const f32x2* ML3, bf16_t* Y) {
    const int tid = opaque_tid(), G = gridDim.x;
    constexpr int NU = 6144;
    int au = blockIdx.x;
    if (au >= NU) return;
    u32x4 krA[4], vrA[4], krB[4], vrB[4]; bf16x8 qA[2], qB[2]; AttnCur cA, cB; int hA, hB;
    attn_load(Z, au, d, tid, krA, vrA, qA, cA, hA);
    attn_load(Z, (au + G < NU) ? au + G : au, d, tid, krB, vrB, qB, cB, hB);
    for (;;) {
        attn_step<FINAL>(lds, Z, d, OP, ML, OP2, OP3, ML2, ML3, Y, au, G, tid, krA, vrA, qA, cA, hA);
        au += G; if (au >= NU) break;
        attn_step<FINAL>(lds, Z, d, OP, ML, OP2, OP3, ML2, ML3, Y, au, G, tid, krB, vrB, qB, cB, hB);
        au += G; if (au >= NU) break;
    }
}
constexpr int A2_ROWS = 384, A2_V_OFF = A2_ROWS * KSTR;
struct Attn2Cur { int qtok0, f0, Ld, dstep, p16; };
template <bool FINAL>
__device__ __forceinline__ void attn2_load(const bf16_t* Z, int au, int d, int tid, u32x4 (&kr)[6], u32x4 (&vr)[6], Attn2Cur& c, int& hh) {
    const int lane = tid & 63, w = tid >> 6, fr = lane & 15, fq = lane >> 4;
    const int h = au & 7, v = au >> 3, reg = FINAL ? 0 : (v >> 5), r = FINAL ? 0 : (v & 31);
    int b, rb, S; row_info(FINAL ? v * 256 : reg * 4096, b, rb, S);
    const int rpos = (FINAL ? v * 256 : reg * 4096) - rb;
    const int ld = FINAL ? 0 : ((r < 16) ? 4 : 2); d = 1 << ld;
    const int rho = FINAL ? 0 : ((r < 16) ? r : ((r - 16) >> 2));
    const int f0 = (rpos >> ld) + ((FINAL || r < 16) ? 0 : ((r - 16) & 3) * 256), Ld = S >> ld;
#pragma unroll
    for (int it = 0; it < 6; ++it) {
        const int idx = tid + NTHR * it, row = idx >> 3, ch = idx & 7, fk = f0 - 64 + row;
        u32x4 kv = {0u, 0u, 0u, 0u}, vv = {0u, 0u, 0u, 0u};
        if (fk >= 0 && fk < Ld) { const bf16_t* zr = Z + (size_t)(rb + fk * d + rho) * PROJ + h * 64 + ch * 8; kv = *(const u32x4*)(zr + 768); vv = *(const u32x4*)(zr + 1280); }
        kr[it] = kv; vr[it] = vv;
    }
    c.qtok0 = rb + (f0 + 32 * w + fr) * d + rho; c.dstep = 16 * d; c.f0 = f0; c.Ld = Ld; c.p16 = (r < 16) ? 1 : 0; hh = h;
}
__device__ __forceinline__ void attn2_loadq(const bf16_t* Z, const Attn2Cur& c, int h, int fq, bf16x8 (&qf)[2][2]) {
#pragma unroll
    for (int qi = 0; qi < 2; ++qi)
#pragma unroll
        for (int kk = 0; kk < 2; ++kk) qf[qi][kk] = *(const bf16x8*)(Z + (size_t)(c.qtok0 + qi * c.dstep) * PROJ + 256 + h * 64 + 8 * fq + 32 * kk);
}
template <bool FINAL>
__device__ __forceinline__ void attn2_phase(LAS unsigned char* lds, const bf16_t* Z, bf16_t* OP16, f32x2* ML16, bf16_t* OP4, f32x2* ML4, bf16_t* Y) {
    const int d = 0;
    const int tid = opaque_tid(), lane = tid & 63, w = tid >> 6, fr = lane & 15, fq = lane >> 4, G = gridDim.x;
    constexpr int NU = FINAL ? 3072 : 24 * 32 * 8;
    u32x4 kr[6], vr[6]; bf16x8 qf[2][2]; Attn2Cur cn; int hn;
    int au = blockIdx.x;
    if (au >= NU) return;
    attn2_load<FINAL>(Z, au, d, tid, kr, vr, cn, hn);
    attn2_loadq(Z, cn, hn, fq, qf);
    for (; au < NU; au += G) {
#pragma unroll
        for (int it = 0; it < 6; ++it) { const int idx = tid + NTHR * it, row = idx >> 3, ch = idx & 7;
            *(LAS u32x4*)(lds + row * KSTR + ch * 16) = kr[it]; *(LAS u32x4*)(lds + A2_V_OFF + row * VSTR + ch * 16) = vr[it]; }
        const Attn2Cur c = cn; const int h = hn;
        __syncthreads();
        { const int an = (au + G < NU) ? au + G : au; attn2_load<FINAL>(Z, an, d, tid, kr, vr, cn, hn); }
        f32x4 st[2][9];
#pragma unroll
        for (int qi = 0; qi < 2; ++qi)
#pragma unroll
            for (int tt = 0; tt < 9; ++tt) st[qi][tt] = (f32x4){0.f, 0.f, 0.f, 0.f};
#pragma unroll
        for (int kk = 0; kk < 2; ++kk) {
#pragma unroll
            for (int kh = 0; kh < 2; ++kh) {
                bf16x8 kf[5];
#pragma unroll
                for (int i = 0; i < 5; ++i) kf[i] = *(const LAS bf16x8*)(lds + (32 * w + 16 * (5 * kh + i) + fr) * KSTR + (8 * fq + 32 * kk) * 2);
                asm volatile("s_waitcnt lgkmcnt(0)" ::: "memory");
                __builtin_amdgcn_sched_barrier(0);
#pragma unroll
                for (int i = 0; i < 5; ++i) { const int kt = 5 * kh + i;
                    if (kt < 9) st[0][kt] = mfma32(kf[i], qf[0][kk], st[0][kt]);
                    if (kt > 0) st[1][kt - 1] = mfma32(kf[i], qf[1][kk], st[1][kt - 1]);
                }
                __builtin_amdgcn_sched_barrier(0);
            }
        }
        attn2_loadq(Z, cn, hn, fq, qf);
        float mx[2], lsum[2];
        const int fkb = c.f0 + 32 * w - 64;
        const bool edge = (fkb < 0) || (fkb + 160 > c.Ld);
#pragma unroll
        for (int qi = 0; qi < 2; ++qi) {
            float m = -1e30f;
#pragma unroll
            for (int j = 0; j < 4; ++j) { if (4 * fq + j < fr) st[qi][0][j] = -1e30f; if (4 * fq + j > fr) st[qi][8][j] = -1e30f; }
            if (edge) {
#pragma unroll
                for (int tt = 0; tt < 9; ++tt)
#pragma unroll
                    for (int j = 0; j < 4; ++j) { const int fk = fkb + 16 * (qi + tt) + 4 * fq + j; if (fk < 0 || fk >= c.Ld) st[qi][tt][j] = -1e30f; }
            }
#pragma unroll
            for (int tt = 0; tt < 9; ++tt) m = fmaxf(m, fmaxf(fmaxf(st[qi][tt][0], st[qi][tt][1]), fmaxf(st[qi][tt][2], st[qi][tt][3])));
            m = fmaxf(m, __shfl_xor(m, 16)); m = fmaxf(m, __shfl_xor(m, 32));
            float l = 0.f;
#pragma unroll
            for (int tt = 0; tt < 9; ++tt)
#pragma unroll
                for (int j = 0; j < 4; ++j) { const float p = __builtin_amdgcn_exp2f(st[qi][tt][j] - m); st[qi][tt][j] = p; l += p; }
            l += __shfl_xor(l, 16); l += __shfl_xor(l, 32);
            mx[qi] = m; lsum[qi] = l;
            __builtin_amdgcn_sched_barrier(0);
        }
        u32x2 pp[2][9];
#pragma unroll
        for (int qi = 0; qi < 2; ++qi)
#pragma unroll
            for (int tt = 0; tt < 9; ++tt) { pp[qi][tt].x = pk_bf16(st[qi][tt][0], st[qi][tt][1]); pp[qi][tt].y = pk_bf16(st[qi][tt][2], st[qi][tt][3]); }
        __builtin_amdgcn_sched_barrier(0);
        u32x2 o16[2][4], o4[2][4]; f32x2 a16[2], a4[2];
        if (FINAL) {
#pragma unroll
            for (int qi = 0; qi < 2; ++qi) { const int qtok = c.qtok0 + qi * c.dstep;
                a16[qi] = ML16[(size_t)qtok * 8 + h]; a4[qi] = ML4[(size_t)qtok * 8 + h];
                const bf16_t* p16 = OP16 + (size_t)qtok * 512 + h * 64 + 4 * fq; const bf16_t* p4 = OP4 + (size_t)qtok * 512 + h * 64 + 4 * fq;
#pragma unroll
                for (int dd = 0; dd < 4; ++dd) { o16[qi][dd] = *(const u32x2*)(p16 + 16 * dd); o4[qi][dd] = *(const u32x2*)(p4 + 16 * dd); } }
            __builtin_amdgcn_sched_barrier(0);
        }
        f32x4 ot[2][4];
#pragma unroll
        for (int qi = 0; qi < 2; ++qi)
#pragma unroll
            for (int dd = 0; dd < 4; ++dd) ot[qi][dd] = (f32x4){0.f, 0.f, 0.f, 0.f};
        const int tg = lane >> 4, tq = (lane >> 2) & 3, tp = lane & 3;
        const LAS unsigned char* vb = lds + A2_V_OFF + (32 * w + 4 * tg + tq) * VSTR + tp * 8;
#pragma unroll
        for (int ks = 0; ks < 5; ++ks) {
            bf16x4 vlo[4], vhi[4];
#pragma unroll
            for (int dd = 0; dd < 4; ++dd) { vlo[dd] = tr4(vb + (32 * ks) * VSTR + dd * 32); vhi[dd] = tr4(vb + (32 * ks + 16) * VSTR + dd * 32); }
            u32x4 pw0, pw1;
            pw0.x = pp[0][2 * ks].x; pw0.y = pp[0][2 * ks].y;
            if (ks < 4) { pw0.z = pp[0][2 * ks + 1].x; pw0.w = pp[0][2 * ks + 1].y; } else { pw0.z = 0u; pw0.w = 0u; }
            if (ks > 0) { pw1.x = pp[1][2 * ks - 1].x; pw1.y = pp[1][2 * ks - 1].y; } else { pw1.x = 0u; pw1.y = 0u; }
            pw1.z = pp[1][2 * ks].x; pw1.w = pp[1][2 * ks].y;
            const bf16x8 pf0 = __builtin_bit_cast(bf16x8, pw0), pf1 = __builtin_bit_cast(bf16x8, pw1);
            asm volatile("s_waitcnt lgkmcnt(0)" ::: "memory");
            __builtin_amdgcn_sched_barrier(0);
#pragma unroll
            for (int dd = 0; dd < 4; ++dd) { const bf16x4 lo = vlo[dd], hi = vhi[dd];
                const bf16x8 vf = {lo[0], lo[1], lo[2], lo[3], hi[0], hi[1], hi[2], hi[3]};
                ot[0][dd] = mfma32(vf, pf0, ot[0][dd]); ot[1][dd] = mfma32(vf, pf1, ot[1][dd]); }
            __builtin_amdgcn_sched_barrier(0);
        }
#pragma unroll
        for (int qi = 0; qi < 2; ++qi) {
            const int qtok = c.qtok0 + qi * c.dstep;
            if (!FINAL) {
                const float inv = 1.0f / lsum[qi];
                bf16_t* op = (c.p16 ? OP16 : OP4) + (size_t)qtok * 512 + h * 64 + 4 * fq;
#pragma unroll
                for (int dd = 0; dd < 4; ++dd) { u32x2 o; o.x = pk_bf16(ot[qi][dd][0] * inv, ot[qi][dd][1] * inv); o.y = pk_bf16(ot[qi][dd][2] * inv, ot[qi][dd][3] * inv); *(u32x2*)(op + 16 * dd) = o; }
                if (fq == 0) (c.p16 ? ML16 : ML4)[(size_t)qtok * 8 + h] = (f32x2){mx[qi], lsum[qi]};
            } else {
                const f32x2 a2 = a4[qi], a3 = a16[qi];
                const float M = fmaxf(mx[qi], fmaxf(a2.x, a3.x));
                const float w1 = __builtin_amdgcn_exp2f(mx[qi] - M), w2 = a2.y * __builtin_amdgcn_exp2f(a2.x - M), w3 = a3.y * __builtin_amdgcn_exp2f(a3.x - M);
                const float inv = 1.0f / (lsum[qi] * w1 + w2 + w3);
                const float c1 = w1 * inv, c2 = w2 * inv, c3 = w3 * inv;
                bf16_t* yp = Y + (size_t)qtok * DM + 256 + h * 64 + 4 * fq;
#pragma unroll
                for (int dd = 0; dd < 4; ++dd) { const u32x2 p2 = o4[qi][dd], p3 = o16[qi][dd];
                    const float y0 = ot[qi][dd][0] * c1 + bf_lo(p2.x) * c2 + bf_lo(p3.x) * c3, y1 = ot[qi][dd][1] * c1 + bf_hi(p2.x) * c2 + bf_hi(p3.x) * c3;
                    const float y2 = ot[qi][dd][2] * c1 + bf_lo(p2.y) * c2 + bf_lo(p3.y) * c3, y3 = ot[qi][dd][3] * c1 + bf_hi(p2.y) * c2 + bf_hi(p3.y) * c3;
                    u32x2 o; o.x = pk_bf16(y0, y1); o.y = pk_bf16(y2, y3); *(u32x2*)(yp + 16 * dd) = o; }
            }
        }
        __syncthreads();
    }
}

constexpr int PSTR = 528;
__device__ __forceinline__ void pool_load(const bf16_t* Z, int tile, int tid, u32x4 (&pr)[9]) {
    int b, rb, S; row_info(tile * 128, b, rb, S);
    const int p0 = tile * 128 - rb - 8;
#pragma unroll
    for (int it = 0; it < 9; ++it) { const int idx = tid + NTHR * it, row = idx >> 5, ch = idx & 31, j = p0 + row;
        u32x4 v = {0u, 0u, 0u, 0u};
        if (j >= 0 && j < S) v = *(const u32x4*)(Z + (size_t)(rb + j) * PROJ + ch * 8);
        pr[it] = v; }
}
template <int G_>
__device__ __forceinline__ void pool_tiles(LAS unsigned char* lds, bf16_t* Y, const bf16x8 (&wf)[2][4], const f32x4 (&sc)[4], int S, int rb, int tile, int half, int fr, int fq) {
    constexpr int HW = 1 << G_;
#pragma unroll 1
    for (int mt = 0; mt < 4; ++mt) {
        const int tl = half * 64 + mt * 16 + fr, token = tile * 128 + tl, pos = token - rb;
        const int lo = (pos - HW > 0) ? pos - HW : 0, hi = (pos + HW < S) ? pos + HW : S;
        const float inv = 1.0f / (float)(hi - lo);
        f32x4 acc[4];
#pragma unroll
        for (int dd = 0; dd < 4; ++dd) acc[dd] = (f32x4){0.f, 0.f, 0.f, 0.f};
#pragma unroll
        for (int kk = 0; kk < 2; ++kk) {
            const LAS unsigned char* base = lds + (tl + 8 - HW) * PSTR + (G_ * 64 + 32 * kk + 8 * fq) * 2;
            float s[8];
#pragma unroll
            for (int i = 0; i < 8; ++i) s[i] = 0.f;
#pragma unroll
            for (int jj = 0; jj < 2 * HW; ++jj) {
                const u32x4 v = *(const LAS u32x4*)(base + jj * PSTR);
                s[0] += bf_lo(v.x); s[1] += bf_hi(v.x); s[2] += bf_lo(v.y); s[3] += bf_hi(v.y);
                s[4] += bf_lo(v.z); s[5] += bf_hi(v.z); s[6] += bf_lo(v.w); s[7] += bf_hi(v.w);
            }
            const u32x4 sv = *(const LAS u32x4*)(base + HW * PSTR);
            u32x4 pw;
            pw.x = pk_bf16(s[0] * inv - bf_lo(sv.x), s[1] * inv - bf_hi(sv.x)); pw.y = pk_bf16(s[2] * inv - bf_lo(sv.y), s[3] * inv - bf_hi(sv.y));
            pw.z = pk_bf16(s[4] * inv - bf_lo(sv.z), s[5] * inv - bf_hi(sv.z)); pw.w = pk_bf16(s[6] * inv - bf_lo(sv.w), s[7] * inv - bf_hi(sv.w));
            const bf16x8 pf = __builtin_bit_cast(bf16x8, pw);
#pragma unroll
            for (int dd = 0; dd < 4; ++dd) acc[dd] = mfma32(wf[kk][dd], pf, acc[dd]);
        }
#pragma unroll
        for (int dd = 0; dd < 4; ++dd) { const f32x4 o = acc[dd] * sc[dd];
            u32x2 ow; ow.x = pk_bf16(o.x, o.y); ow.y = pk_bf16(o.z, o.w); *(u32x2*)(Y + (size_t)token * DM + G_ * 64 + 16 * dd + 4 * fq) = ow; }
    }
}
__device__ __forceinline__ void pool_phase(LAS unsigned char* lds, const bf16_t* Z, bf16_t* Y, const bf16_t* pwt, const float* pscale) {
    const int tid = opaque_tid(), lane = tid & 63, w = __builtin_amdgcn_readfirstlane(tid >> 6), fr = lane & 15, fq = lane >> 4, G = gridDim.x;
    constexpr int NU = 768;
    int tile = blockIdx.x;
    if (tile >= NU) return;
    u32x4 pr[9];
    pool_load(Z, tile, tid, pr);
    const int g = w & 3, half = w >> 2;
    bf16x8 wf[2][4]; f32x4 sc[4];
#pragma unroll
    for (int kk = 0; kk < 2; ++kk)
#pragma unroll
        for (int dd = 0; dd < 4; ++dd) wf[kk][dd] = *(const bf16x8*)(pwt + (size_t)(g * 64 + 16 * dd + fr) * 64 + 32 * kk + 8 * fq);
#pragma unroll
    for (int dd = 0; dd < 4; ++dd) sc[dd] = *(const f32x4*)(pscale + g * 64 + 16 * dd + 4 * fq);
    for (; tile < NU; tile += G) {
#pragma unroll
        for (int it = 0; it < 9; ++it) { const int idx = tid + NTHR * it, row = idx >> 5, ch = idx & 31; *(LAS u32x4*)(lds + row * PSTR + ch * 16) = pr[it]; }
        __syncthreads();
        { const int tn = (tile + G < NU) ? tile + G : tile; pool_load(Z, tn, tid, pr); }
        int b, rb, S; row_info(tile * 128, b, rb, S);
        if (g == 0) pool_tiles<0>(lds, Y, wf, sc, S, rb, tile, half, fr, fq);
        else if (g == 1) pool_tiles<1>(lds, Y, wf, sc, S, rb, tile, half, fr, fq);
        else if (g == 2) pool_tiles<2>(lds, Y, wf, sc, S, rb, tile, half, fr, fq);
        else pool_tiles<3>(lds, Y, wf, sc, S, rb, tile, half, fr, fq);
        __syncthreads();
    }
}
__device__ __forceinline__ void sgu_load(const bf16_t* Z, int un, int tid, u32x4 (&vr)[2], u32x2 (&uv)[4]) {
    const int tile = un >> 2, g = un & 3, lane = tid & 63, w = tid >> 6, fr = lane & 15, fq = lane >> 4;
#pragma unroll
    for (int it = 0; it < 2; ++it) { const int idx = tid + NTHR * it, row = idx >> 3, ch = idx & 7; vr[it] = *(const u32x4*)(Z + (size_t)(tile * 128 + row) * PROJ + 2048 + g * 64 + ch * 8); }
#pragma unroll
    for (int cc = 0; cc < 4; ++cc) uv[cc] = *(const u32x2*)(Z + (size_t)(tile * 128 + 16 * w + fr) * PROJ + 1792 + g * 64 + 16 * cc + 4 * fq);
}
__device__ __forceinline__ void sgu_phase(LAS unsigned char* lds, const bf16_t* Z, bf16_t* Y, const bf16_t* sw, const float* sb) {
    const int tid = opaque_tid(), lane = tid & 63, w = tid >> 6, fr = lane & 15, fq = lane >> 4, G = gridDim.x;
    constexpr int NU = 3072;
    int un = blockIdx.x;
    if (un >= NU) return;
    u32x4 vr[2]; u32x2 un_uv[4];
    sgu_load(Z, un, tid, vr, un_uv);
    int gcur = -1; u32x2 wlo[4], whi[4]; float bias = 0.f;
    for (; un < NU; un += G) {
        const int tile = un >> 2, g = un & 3, t0 = tile * 128;
        if (g != gcur) { gcur = g;
            const bf16_t* wrow = sw + (size_t)(g * 128 + 16 * w + fr) * 128 + 4 * fq;
#pragma unroll
            for (int ks = 0; ks < 4; ++ks) { wlo[ks] = *(const u32x2*)(wrow + 32 * ks); whi[ks] = *(const u32x2*)(wrow + 32 * ks + 16); }
            bias = sb[g * 128 + 16 * w + fr]; }
#pragma unroll
        for (int it = 0; it < 2; ++it) {
            const int idx = tid + NTHR * it, row = idx >> 3, ch = idx & 7;
            const u32x4 v = vr[it];
            float x[8] = {bf_lo(v.x), bf_hi(v.x), bf_lo(v.y), bf_hi(v.y), bf_lo(v.z), bf_hi(v.z), bf_lo(v.w), bf_hi(v.w)};
            float s = ((x[0] + x[1]) + (x[2] + x[3])) + ((x[4] + x[5]) + (x[6] + x[7]));
            s += __shfl_xor(s, 1); s += __shfl_xor(s, 2); s += __shfl_xor(s, 4);
            const float mu = s * (1.0f / 64.0f);
            float q = 0.f;
#pragma unroll
            for (int i = 0; i < 8; ++i) { x[i] -= mu; q += x[i] * x[i]; }
            q += __shfl_xor(q, 1); q += __shfl_xor(q, 2); q += __shfl_xor(q, 4);
            const float rstd = 1.0f / sqrtf(q * (1.0f / 64.0f) + EPS);
            u32x4 o; o.x = pk_bf16(x[0] * rstd, x[1] * rstd); o.y = pk_bf16(x[2] * rstd, x[3] * rstd); o.z = pk_bf16(x[4] * rstd, x[5] * rstd); o.w = pk_bf16(x[6] * rstd, x[7] * rstd);
            *(LAS u32x4*)(lds + row * VSTR + ch * 16) = o;
        }
        __syncthreads();
        const int token = t0 + 16 * w + fr;
        u32x2 uv[4];
#pragma unroll
        for (int cc = 0; cc < 4; ++cc) uv[cc] = un_uv[cc];
        { const int nn = (un + G < NU) ? un + G : un; sgu_load(Z, nn, tid, vr, un_uv); }
        f32x4 acc[4];
#pragma unroll
        for (int cc = 0; cc < 4; ++cc) acc[cc] = (f32x4){0.f, 0.f, 0.f, 0.f};
        const int tg = lane >> 4, tq = (lane >> 2) & 3, tp = lane & 3;
        const LAS unsigned char* vb = lds + (4 * tg + tq) * VSTR + tp * 8;
#pragma unroll
        for (int ks = 0; ks < 4; ++ks) {
            const u32x4 ww = {wlo[ks].x, wlo[ks].y, whi[ks].x, whi[ks].y};
            const bf16x8 wf = __builtin_bit_cast(bf16x8, ww);
#pragma unroll
            for (int cc = 0; cc < 4; ++cc) { const bf16x4 lo = tr4(vb + (32 * ks) * VSTR + cc * 32), hi = tr4(vb + (32 * ks + 16) * VSTR + cc * 32);
                const bf16x8 vf = {lo[0], lo[1], lo[2], lo[3], hi[0], hi[1], hi[2], hi[3]}; acc[cc] = mfma32(vf, wf, acc[cc]); }
        }
#pragma unroll
        for (int cc = 0; cc < 4; ++cc) {
            u32x2 o; o.x = pk_bf16((acc[cc][0] + bias) * bf_lo(uv[cc].x), (acc[cc][1] + bias) * bf_hi(uv[cc].x)); o.y = pk_bf16((acc[cc][2] + bias) * bf_lo(uv[cc].y), (acc[cc][3] + bias) * bf_hi(uv[cc].y));
            *(u32x2*)(Y + (size_t)token * DM + 768 + g * 64 + 16 * cc + 4 * fq) = o; }
        __syncthreads();
    }
}

#define XB_TMO      128
#define XB_XCNT(j)  (256  + 64 * (j))
#define XB_XSUB(j)  (1280 + 64 * (j))
#define XB_XGEN(j)  (2304 + 64 * (j))
#define XB_TOP      3328
#define XB_TOPGEN   3392
#define XCD_BAR_WORDS 3456
#define XB_SPIN_CAP (1u << 18)

__device__ __forceinline__ unsigned xb_ld(unsigned* p)              { return __hip_atomic_load(p, __ATOMIC_RELAXED, __HIP_MEMORY_SCOPE_AGENT); }
__device__ __forceinline__ unsigned xb_add(unsigned* p, unsigned v) { return __hip_atomic_fetch_add(p, v, __ATOMIC_RELAXED, __HIP_MEMORY_SCOPE_AGENT); }
__device__ __forceinline__ unsigned xb_xcc_id() { return (unsigned)__builtin_amdgcn_s_getreg((3 << 11) | 20) & 0xFu; }
#define XB_SPIN(cond, bar) do { unsigned _sp = 0; while (cond) { __builtin_amdgcn_s_sleep(1); \
    if ((++_sp & 255u) == 0u) { if (xb_ld(&(bar)[XB_TMO])) break; if (_sp > XB_SPIN_CAP) { atomicAdd(&(bar)[XB_TMO], 1u); break; } } } } while (0)

struct XcdBarrier {
    unsigned* bar; unsigned x;
    volatile LAS unsigned* st;
};

__device__ __forceinline__ XcdBarrier xcd_barrier_post(unsigned* bar, volatile LAS unsigned* st) {
    XcdBarrier b; b.bar = bar; b.x = xb_xcc_id(); b.st = st;
    if (threadIdx.x == 0) (void)xb_add(&bar[XB_XCNT(b.x)], 1u);
    return b;
}
__device__ __forceinline__ void xcd_barrier_complete(unsigned* bar, unsigned x, unsigned& nloc, unsigned& nx) {
    const unsigned G = gridDim.x * gridDim.y * gridDim.z;
    unsigned sum, cnt, mine, sp = 0u;
    for (;;) {
        sum = 0u; cnt = 0u; mine = 0u;
#pragma unroll
        for (unsigned j = 0; j < 16; ++j) { const unsigned c = xb_ld(&bar[XB_XCNT(j)]); sum += c; cnt += (c > 0u) ? 1u : 0u; mine = (j == x) ? c : mine; }
        if (sum == G) break;
        __builtin_amdgcn_s_sleep(1);
        if ((++sp & 255u) == 0u) { if (xb_ld(&bar[XB_TMO])) break; if (sp > XB_SPIN_CAP) { atomicAdd(&bar[XB_TMO], 1u); break; } }
    }
    nloc = mine > 0u ? mine : 1u; nx = cnt > 0u ? cnt : 1u;
}

__device__ __forceinline__ void xcd_barrier(const XcdBarrier& b) {
    asm volatile("s_waitcnt vmcnt(0)" ::: "memory");
    __syncthreads();
    if (threadIdx.x == 0) {
        unsigned* bar = b.bar;
        __builtin_amdgcn_s_waitcnt(0);
        unsigned nloc = b.st[0], nx = b.st[1];
        if (nloc == 0u) { xcd_barrier_complete(bar, b.x, nloc, nx); b.st[0] = nloc; b.st[1] = nx; }
        const unsigned old = xb_add(&bar[XB_XSUB(b.x)], 1u);
        const unsigned gen = old / nloc;
        if (old + 1u == (gen + 1u) * nloc) {
            __builtin_amdgcn_fence(__ATOMIC_RELEASE, "agent");
            asm volatile("s_waitcnt vmcnt(0)" ::: "memory");
            const unsigned og = xb_add(&bar[XB_TOP], 1u);
            const unsigned tg = og / nx;
            if (og + 1u == (tg + 1u) * nx) xb_add(&bar[XB_TOPGEN], 1u);
            else XB_SPIN(xb_ld(&bar[XB_TOPGEN]) == tg, bar);
            __builtin_amdgcn_fence(__ATOMIC_ACQUIRE, "agent");
            xb_add(&bar[XB_XGEN(b.x)], 1u);
            asm volatile("s_waitcnt vmcnt(0)" ::: "memory");
        } else {
            XB_SPIN(xb_ld(&bar[XB_XGEN(b.x)]) == gen, bar);
            __builtin_amdgcn_fence(__ATOMIC_ACQUIRE, "agent");
            asm volatile("s_waitcnt vmcnt(0)" ::: "memory");
        }
    }
    __syncthreads();
}

constexpr int N_PHASES = 15;
__global__ void __launch_bounds__(NTHR, 2) fwd_kernel(Args A) {
    extern __shared__ __attribute__((aligned(16))) unsigned char lds_raw[];
    LAS unsigned char* lds = (LAS unsigned char*)lds_raw;
    cg::grid_group grid = cg::this_grid();
    unsigned char* ws = A.ws;
    const int G = gridDim.x;
    bf16_t* H = (bf16_t*)(ws + WS_H); bf16_t* Zb = (bf16_t*)(ws + WS_Z); bf16_t* Yb = (bf16_t*)(ws + WS_Y); bf16_t* Ub = (bf16_t*)(ws + WS_U);
    bf16_t* OP2 = (bf16_t*)A.out; bf16_t* OP3 = (bf16_t*)A.out + (size_t)TT * 512;
    f32x2* ML2 = (f32x2*)(ws + WS_ML2); f32x2* ML3 = (f32x2*)(ws + WS_ML3);
    const float* mod = (const float*)(ws + WS_MOD);
    const int lo = A.ph_lo, hi = A.ph_hi;
#ifndef PHMASK
#define PHMASK 0x1FF
#endif
#define PM(i) (((PHMASK) >> (i)) & 1)
#ifndef REP_N1
#define REP_N1 1
#endif
#ifndef REP_G1
#define REP_G1 1
#endif
#ifndef REP_MA
#define REP_MA 1
#endif
#ifndef REP_MB
#define REP_MB 1
#endif
#ifndef REP_G3
#define REP_G3 1
#endif
#define IN(k) (lo <= (k) && (k) < hi)
    volatile LAS unsigned* xb_st = (volatile LAS unsigned*)(lds + 131072 + 64);
    if (threadIdx.x < 2) xb_st[threadIdx.x] = 0u;
    __syncthreads();
    XcdBarrier xbar; xbar.bar = (unsigned*)(ws + WS_BAR); xbar.x = 0; xbar.st = xb_st;
#define SEAM(k) do { if (IN(k) && IN((k) + 1)) { if ((k) == 0) { grid.sync(); xbar = xcd_barrier_post((unsigned*)(ws + WS_BAR), xb_st); } else xcd_barrier(xbar); } } while (0)
    if (PM(0) && IN(0)) { p0_prologue(A, lds); }
    SEAM(0);
    float* rowsq = (float*)(ws + WS_ROWSQ); float* shw = (float*)(ws + WS_SHW);
    if (PM(1) && IN(1)) prep_phase(A.x_p, A.x_s, A.g_mix, mod, H, rowsq, mod, (const bf16_t*)(ws + WS_WIN), (const bf16_t*)(ws + WS_WUP), shw);
    SEAM(1);
    for (int l = 0; l < 2; ++l) {
        const int pb = 2 + 6 * l;
        const float* modl = mod + (size_t)l * NB * 6144;
        const float* shwl = shw + (size_t)l * (NB * 6400);
        if (PM(2) && IN(pb + 0)) for (int rep = 0; rep < REP_G1; ++rep) {
            pg8::Gemm g{H, (const bf16_t*)(ws + WS_WIN) + (size_t)l * PROJ * DM, TT, PROJ, DM}; pg8::StaticOrder S; S.init(TT, PROJ, G, (int)blockIdx.x);
            pg8::EpiZ E{Zb, (const float*)(ws + WS_ROPE), rowsq + (size_t)(2 * l) * TT, shwl};
            pg8::gemm_phase<pg8::EpiZ, pg8::StaticOrder, true, true>(lds, g, S, E);
        }
        SEAM(pb + 0);
        if (PM(3) && IN(pb + 1)) for (int rep = 0; rep < REP_MA; ++rep) {
            const bf16_t* pwt = (const bf16_t*)(ws + WS_PWT) + (size_t)l * 4 * 4096; const bf16_t* sw = (const bf16_t*)(ws + WS_SGUW) + (size_t)l * 4 * 16384;
            attn2_phase<false>(lds, Zb, OP3, ML3, OP2, ML2, nullptr);
            sgu_phase(lds, Zb, Yb, sw, A.sgu_b + l * 512);
            pool_phase(lds, Zb, Yb, pwt, A.pool_scale + l * 256);
        }
        SEAM(pb + 1);
        if (PM(4) && IN(pb + 2)) for (int rep = 0; rep < REP_MB; ++rep) {
            attn2_phase<true>(lds, Zb, OP3, ML3, OP2, ML2, Yb);
        }
        SEAM(pb + 2);
        if (PM(5) && IN(pb + 3)) {
            pg8::Gemm g{Yb, (const bf16_t*)(ws + WS_WOUT) + (size_t)l * DM * DM, TT, DM, DM}; pg8::StaticOrder S; S.init(TT, DM, G, (int)blockIdx.x);
            pg8::EpiRes E{A.x_p, A.x_s, H, A.g_mix + l * DM, modl + 1024, modl + 2048, H, A.g_mlp + l * DM, modl + 4096, rowsq + (size_t)(2 * l + 1) * TT};
            pg8::gemm_phase<pg8::EpiRes, pg8::StaticOrder, true, true>(lds, g, S, E);
        }
        SEAM(pb + 3);
        if (PM(6) && IN(pb + 4)) for (int rep = 0; rep < REP_G3; ++rep) {
            pg8::Gemm g{H, (const bf16_t*)(ws + WS_WUP) + (size_t)l * DFF * DM, TT, DFF, DM}; pg8::StaticOrder S; S.init(TT, DFF, G, (int)blockIdx.x);
            pg8::EpiRelu2 E{Ub, DFF, rowsq + (size_t)(2 * l + 1) * TT, shwl + NB * 2304};
            pg8::gemm_phase<pg8::EpiRelu2, pg8::StaticOrder, true, true>(lds, g, S, E);
        }
        SEAM(pb + 4);
        if (PM(7) && IN(pb + 5)) {
            pg8::Gemm g{Ub, (const bf16_t*)(ws + WS_WDOWN) + (size_t)l * DM * DFF, TT, DM, DFF}; pg8::StaticOrder S; S.init(TT, DM, G, (int)blockIdx.x, 1);
            pg8::EpiRes E{A.x_p, A.x_s, H, A.g_mlp + l * DM, modl + 4096, modl + 5120, H, (l == 0) ? A.g_mix + DM : A.g_final, (l == 0) ? mod + (size_t)NB * 6144 + 1024 : (const float*)nullptr, rowsq + (size_t)(2 * l + 2) * TT};
            pg8::gemm_phase<pg8::EpiRes, pg8::StaticOrder, true, true>(lds, g, S, E);
        }
        SEAM(pb + 5);
    }
    if (PM(8) && IN(14)) final_norm_phase(A.out, H, rowsq + (size_t)4 * TT);
#undef IN
#undef SEAM
}

#ifndef MK_SPLIT
#define MK_SPLIT 0
#endif
extern "C" void kernel_launch(void* const* d_in, const int* in_sizes, int n_in, void* d_out, int out_size, void* d_ws, size_t ws_size, hipStream_t stream) {
    static int grid = 0;
    if (grid == 0) {
        if (n_in != 17 || out_size != TT * DM || ws_size < WS_END) { fprintf(stderr, "kernel_launch: unexpected shapes: n_in %d out %d ws %zu\n", n_in, out_size, ws_size); grid = -1; return; }
        int dev = 0, cus = 0, per_cu = 0;
        hipGetDevice(&dev); hipDeviceGetAttribute(&cus, hipDeviceAttributeMultiprocessorCount, dev);
        if (hipFuncSetAttribute((const void*)fwd_kernel, hipFuncAttributeMaxDynamicSharedMemorySize, LDS_BYTES) != hipSuccess) { fprintf(stderr, "kernel_launch: hipFuncSetAttribute failed\n"); grid = -1; return; }
        if (hipOccupancyMaxActiveBlocksPerMultiprocessor(&per_cu, (const void*)fwd_kernel, NTHR, LDS_BYTES) != hipSuccess || per_cu < 1) { fprintf(stderr, "kernel_launch: occupancy query gave %d\n", per_cu); per_cu = 1; }
        (void)hipGetLastError();
        grid = cus * per_cu;
    }
    if (grid < 0) return;
    Args a{};
    a.x_p = (const float*)d_in[0]; a.x_s = (const float*)d_in[1]; a.c_p = (const float*)d_in[2]; a.c_s = (const float*)d_in[3]; a.w_ada = (const float*)d_in[4]; a.b_ada = (const float*)d_in[5];
    a.g_mix = (const float*)d_in[6]; a.g_mlp = (const float*)d_in[7]; a.w_in = (const float*)d_in[8]; a.pool_w = (const float*)d_in[9]; a.pool_scale = (const float*)d_in[10];
    a.sgu_w = (const float*)d_in[11]; a.sgu_b = (const float*)d_in[12]; a.w_out = (const float*)d_in[13]; a.w_up = (const float*)d_in[14]; a.w_down = (const float*)d_in[15]; a.g_final = (const float*)d_in[16];
    a.out = (float*)d_out; a.ws = (unsigned char*)d_ws;
#if MK_SPLIT
    for (int p = 0; p < N_PHASES; ++p) { a.ph_lo = p; a.ph_hi = p + 1; hipLaunchKernelGGL(fwd_kernel, dim3(grid), dim3(NTHR), LDS_BYTES, stream, a); }
#else
    a.ph_lo = 0; a.ph_hi = N_PHASES;
    void* args[] = {&a};
    hipError_t e = hipLaunchCooperativeKernel((const void*)fwd_kernel, dim3(grid), dim3(NTHR), args, LDS_BYTES, stream);
    if (e != hipSuccess) fprintf(stderr, "cooperative launch failed: %s (grid %d)\n", hipGetErrorString(e), grid);
#endif
}
```
